# Optimizing an MI355X kernel written in HIP

```python
import math
import jax, jax.numpy as jnp
from jax import lax
import numpy as np

D_MODEL = 1024
BATCH = 8
SEQ = 2048
DEPTH = 2

D_MIX = D_MODEL
D_SSM = D_MIX // 2
SSM_GROUP = 16
N_SSM_HEADS = D_SSM // SSM_GROUP
SSM_STATE = 64
DT_MIN = 0.001
DT_MAX = 0.1
D_POOL = D_MIX - D_SSM
POOL_WINDOWS = (2, 4, 8, 16)
N_POOL_GROUPS = len(POOL_WINDOWS)
POOL_GROUP_DIM = D_POOL // N_POOL_GROUPS
D_FF = 2816
N_EXPERTS = 8
TOP_K = 2
D_FF_EXPERT = 2816
N_DENSE = (DEPTH + 1) // 2
N_MOE = DEPTH // 2
RMS_EPS = 1e-6

kernel_name = "hybrid_s5_pool_moe_trunk"


def rmsnorm(x, g):
    xf = x.astype(jnp.float32)
    inv = lax.rsqrt(jnp.mean(xf * xf, axis=-1, keepdims=True) + RMS_EPS)
    return (xf * inv * g.astype(jnp.float32)).astype(x.dtype)


def _complex_affine_combine(left, right):
    a1r, a1i, b1r, b1i = left
    a2r, a2i, b2r, b2i = right
    ar = a2r * a1r - a2i * a1i
    ai = a2r * a1i + a2i * a1r
    br = a2r * b1r - a2i * b1i + b2r
    bi = a2r * b1i + a2i * b1r + b2i
    return (ar, ai, br, bi)


def s5_mixer(u, log_dt, a_re, a_im, b_re, b_im, c_re, c_im, d, w_glu, b_glu):
    bsz, L, _ = u.shape
    uf = u.astype(jnp.float32)
    ug = uf.reshape(bsz, L, N_SSM_HEADS, SSM_GROUP)
    dt = jnp.exp(log_dt.astype(jnp.float32))[:, None]
    ar = jnp.minimum(a_re.astype(jnp.float32), -1e-4)
    ai = a_im.astype(jnp.float32)
    mag = jnp.exp(ar * dt)
    lam_re = mag * jnp.cos(ai * dt)
    lam_im = mag * jnp.sin(ai * dt)
    den = ar * ar + ai * ai
    nr = lam_re - 1.0
    ni = lam_im
    coef_re = (nr * ar + ni * ai) / den
    coef_im = (ni * ar - nr * ai) / den
    br = b_re.astype(jnp.float32)
    bi = b_im.astype(jnp.float32)
    bb_re = coef_re[..., None] * br - coef_im[..., None] * bi
    bb_im = coef_re[..., None] * bi + coef_im[..., None] * br
    bu_re = jnp.einsum('blhg,hpg->blhp', ug, bb_re)
    bu_im = jnp.einsum('blhg,hpg->blhp', ug, bb_im)
    shape = (1, L, N_SSM_HEADS, SSM_STATE)
    a_seq_re = jnp.broadcast_to(lam_re[None, None], shape)
    a_seq_im = jnp.broadcast_to(lam_im[None, None], shape)
    _, _, s_re, s_im = lax.associative_scan(
        _complex_affine_combine, (a_seq_re, a_seq_im, bu_re, bu_im), axis=1)
    y = (jnp.einsum('blhp,hgp->blhg', s_re, c_re.astype(jnp.float32))
         - jnp.einsum('blhp,hgp->blhg', s_im, c_im.astype(jnp.float32)))
    y = y.reshape(bsz, L, D_SSM) + d.astype(jnp.float32) * uf
    h = jax.nn.gelu(y)
    out = h * jax.nn.sigmoid(h @ w_glu.astype(jnp.float32) + b_glu.astype(jnp.float32))
    return out.astype(u.dtype)


def pool_mixer(xp, pool_w, pool_scale):
    bsz, L, _ = xp.shape
    xg = xp.astype(jnp.float32).reshape(bsz, L, N_POOL_GROUPS, POOL_GROUP_DIM)
    pos = jnp.arange(L)
    outs = []
    for g, w in enumerate(POOL_WINDOWS):
        xc = xg[:, :, g]
        cs0 = jnp.pad(jnp.cumsum(xc, axis=1), ((0, 0), (1, 0), (0, 0)))
        lag = jnp.pad(cs0, ((0, 0), (w - 1, 0), (0, 0)))[:, :L]
        count = jnp.minimum(pos + 1, w).astype(jnp.float32)[None, :, None]
        outs.append((cs0[:, 1:] - lag) / count - xc)
    pooled = jnp.stack(outs, axis=2)
    mixed = jnp.einsum('blgc,gcd->blgd', pooled, pool_w.astype(jnp.float32))
    out = mixed.reshape(bsz, L, D_POOL) * pool_scale.astype(jnp.float32)
    return out.astype(xp.dtype)


def swiglu(h, w_gate, w_up, w_down):
    return (jax.nn.silu(h @ w_gate) * (h @ w_up)) @ w_down


def moe_swiglu(h, router_w, w_gate, w_up, w_down):
    logits = (h @ router_w).astype(jnp.float32)
    top_v, top_i = lax.top_k(logits, TOP_K)
    top_g = jax.nn.softmax(top_v, axis=-1)
    gates = jnp.sum(jax.nn.one_hot(top_i, N_EXPERTS, dtype=jnp.float32) * top_g[..., None], axis=-2)
    out = jnp.zeros(h.shape, jnp.float32)
    for e in range(N_EXPERTS):
        y_e = swiglu(h, w_gate[e], w_up[e], w_down[e]).astype(jnp.float32)
        out = out + gates[..., e:e + 1] * y_e
    return out.astype(h.dtype)


def setup_inputs(seed: int = 0) -> dict:
    key = jax.random.key(seed)
    ks = jax.random.split(key, 24)
    f32 = jnp.float32

    def nrm(k, shape, scale):
        return jax.random.normal(k, shape, f32) * scale

    H, P, G = N_SSM_HEADS, SSM_STATE, SSM_GROUP
    x = jax.random.normal(ks[0], (BATCH, SEQ, D_MODEL), f32)
    norm_mix_g = 1.0 + nrm(ks[1], (DEPTH, D_MODEL), 0.02)
    w_in = nrm(ks[2], (DEPTH, D_MODEL, D_MIX), D_MODEL ** -0.5)
    ssm_log_dt = jax.random.uniform(ks[3], (DEPTH, H), f32, math.log(DT_MIN), math.log(DT_MAX))
    ssm_a_re = -0.5 + nrm(ks[4], (DEPTH, H, P), 0.01)
    ssm_a_im = jnp.pi * jnp.arange(P, dtype=f32)[None, None, :] + nrm(ks[5], (DEPTH, H, P), 0.01)
    ssm_b_re = nrm(ks[6], (DEPTH, H, P, G), (2.0 * G) ** -0.5)
    ssm_b_im = nrm(ks[7], (DEPTH, H, P, G), (2.0 * G) ** -0.5)
    ssm_c_re = nrm(ks[8], (DEPTH, H, G, P), (2.0 * P) ** -0.5 * 4.0)
    ssm_c_im = nrm(ks[9], (DEPTH, H, G, P), (2.0 * P) ** -0.5 * 4.0)
    ssm_d = nrm(ks[10], (DEPTH, D_SSM), 1.0)
    ssm_w_glu = nrm(ks[11], (DEPTH, D_SSM, D_SSM), D_SSM ** -0.5)
    ssm_b_glu = nrm(ks[12], (DEPTH, D_SSM), 0.02)
    pool_w = nrm(ks[13], (DEPTH, N_POOL_GROUPS, POOL_GROUP_DIM, POOL_GROUP_DIM), POOL_GROUP_DIM ** -0.5)
    pool_scale = 1.0 + nrm(ks[14], (DEPTH, D_POOL), 0.02)
    w_out = nrm(ks[15], (DEPTH, D_MIX, D_MODEL), D_MIX ** -0.5)
    norm_ffn_g = 1.0 + nrm(ks[16], (DEPTH, D_MODEL), 0.02)
    ffn_w_gate = nrm(ks[17], (N_DENSE, D_MODEL, D_FF), D_MODEL ** -0.5)
    ffn_w_up = nrm(ks[18], (N_DENSE, D_MODEL, D_FF), D_MODEL ** -0.5)
    ffn_w_down = nrm(ks[19], (N_DENSE, D_FF, D_MODEL), D_FF ** -0.5)
    router_w = nrm(ks[20], (N_MOE, D_MODEL, N_EXPERTS), D_MODEL ** -0.5)
    moe_w_gate = nrm(ks[21], (N_MOE, N_EXPERTS, D_MODEL, D_FF_EXPERT), D_MODEL ** -0.5)
    moe_w_up = nrm(ks[22], (N_MOE, N_EXPERTS, D_MODEL, D_FF_EXPERT), D_MODEL ** -0.5)
    k_down, k_fin = jax.random.split(ks[23])
    moe_w_down = nrm(k_down, (N_MOE, N_EXPERTS, D_FF_EXPERT, D_MODEL), D_FF_EXPERT ** -0.5)
    final_norm_g = 1.0 + nrm(k_fin, (D_MODEL,), 0.02)
    return {
        "x": x, "norm_mix_g": norm_mix_g, "w_in": w_in,
        "ssm_log_dt": ssm_log_dt, "ssm_a_re": ssm_a_re, "ssm_a_im": ssm_a_im,
        "ssm_b_re": ssm_b_re, "ssm_b_im": ssm_b_im, "ssm_c_re": ssm_c_re, "ssm_c_im": ssm_c_im,
        "ssm_d": ssm_d, "ssm_w_glu": ssm_w_glu, "ssm_b_glu": ssm_b_glu,
        "pool_w": pool_w, "pool_scale": pool_scale, "w_out": w_out,
        "norm_ffn_g": norm_ffn_g, "ffn_w_gate": ffn_w_gate, "ffn_w_up": ffn_w_up, "ffn_w_down": ffn_w_down,
        "router_w": router_w, "moe_w_gate": moe_w_gate, "moe_w_up": moe_w_up, "moe_w_down": moe_w_down,
        "final_norm_g": final_norm_g,
    }


def reference(x, norm_mix_g, w_in, ssm_log_dt, ssm_a_re, ssm_a_im, ssm_b_re, ssm_b_im,
              ssm_c_re, ssm_c_im, ssm_d, ssm_w_glu, ssm_b_glu, pool_w, pool_scale, w_out,
              norm_ffn_g, ffn_w_gate, ffn_w_up, ffn_w_down, router_w, moe_w_gate, moe_w_up,
              moe_w_down, final_norm_g):
    h_res = x
    for i in range(DEPTH):
        h = rmsnorm(h_res, norm_mix_g[i])
        proj = h @ w_in[i]
        u_ssm = proj[..., :D_SSM]
        u_pool = proj[..., D_SSM:]
        y_ssm = s5_mixer(u_ssm, ssm_log_dt[i], ssm_a_re[i], ssm_a_im[i], ssm_b_re[i], ssm_b_im[i],
                         ssm_c_re[i], ssm_c_im[i], ssm_d[i], ssm_w_glu[i], ssm_b_glu[i])
        y_pool = pool_mixer(u_pool, pool_w[i], pool_scale[i])
        mixed = jnp.concatenate([y_ssm, y_pool], axis=-1)
        h_res = h_res + mixed @ w_out[i]
        h = rmsnorm(h_res, norm_ffn_g[i])
        j = i // 2
        if i % 2 == 0:
            y = swiglu(h, ffn_w_gate[j], ffn_w_up[j], ffn_w_down[j])
        else:
            y = moe_swiglu(h, router_w[j], moe_w_gate[j], moe_w_up[j], moe_w_down[j])
        h_res = h_res + y
    return rmsnorm(h_res, final_norm_g)
```

```cpp
#include <hip/hip_runtime.h>
#include <cstdio>
#include <cstdint>

#define LAS __attribute__((address_space(3)))
#define GAS __attribute__((address_space(1)))
typedef unsigned short bf16;
typedef short bf16x8 __attribute__((ext_vector_type(8)));
typedef float f32x4 __attribute__((ext_vector_type(4)));
typedef float f32x2 __attribute__((ext_vector_type(2)));
typedef unsigned u32x4 __attribute__((ext_vector_type(4)));
typedef unsigned u32x2 __attribute__((ext_vector_type(2)));

constexpr int BATCH = 8, SEQ = 2048, D = 1024, M = BATCH * SEQ;
constexpr int DSSM = 512, NH = 32, SG = 16, SP = 64, TC = 16  , NR = M / TC  , UZK = TC * SG + 2 * SP  ;
constexpr int DPOOL = 512, DFF = 2816, NE = 8;
constexpr float RMS_EPS = 1e-6f;
constexpr int NWAVES = 8;

constexpr size_t MiB = 1u << 20;
constexpr size_t WS_CTL = 0, CTL_ZERO_BYTES = 16384;
constexpr size_t WS_STATS = 1 * MiB;
constexpr size_t WS_TOK = 2 * MiB;
constexpr size_t WS_CNT = WS_TOK + 256 * 1024;
constexpr size_t WS_POS = WS_CNT + 16 * 1024;
constexpr size_t WS_ROWTOK = WS_POS + 128 * 1024;
constexpr size_t WS_ROWINV = WS_ROWTOK + 192 * 1024;
constexpr size_t WS_TILES = WS_ROWINV + 192 * 1024;
constexpr size_t WS_LAMT = 3 * MiB;
constexpr size_t WS_MWGU = 4 * MiB;
constexpr size_t WS_MWD = 92 * MiB;
constexpr size_t WS_XB = 136 * MiB;
constexpr size_t WS_MIXED = 168 * MiB;
constexpr size_t WS_WIN = 200 * MiB;
constexpr size_t WS_WGLU = 204 * MiB;
constexpr size_t WS_WOUT = 205 * MiB;
constexpr size_t WS_TW = 209 * MiB;
constexpr size_t WS_WE = 221 * MiB;
constexpr size_t WS_WGU = 229 * MiB;
constexpr size_t WS_WD = 240 * MiB;
constexpr size_t WS_UZ = 246 * MiB;
constexpr size_t WS_E = 270 * MiB;
constexpr size_t WS_V = 286 * MiB;
constexpr size_t WS_H = 302 * MiB;
constexpr size_t WS_HID = 246 * MiB;
constexpr size_t WS_HIDM = 168 * MiB;
constexpr size_t WS_XB8 = 72 * MiB;
constexpr size_t WS_Y = WS_MWGU;
constexpr int NASG = 2 * M;
constexpr size_t WS_END = 346 * MiB;
static_assert(WS_HIDM + (size_t)(NASG + 256) * DFF * 2 <= WS_END && (size_t)(NASG + 4 * 8 * 256) * D * 2 <= WS_MWD - WS_MWGU && WS_TILES + 4096 <= 3 * MiB, "d_ws map");
constexpr int CW_BAR = 0;

constexpr int RING_BYTES = 131072, LDSCTL_OFF = RING_BYTES, MISC_OFF = LDSCTL_OFF + 320, LDS_BYTES = 147456;

#define LDS_WAIT() asm volatile("s_waitcnt lgkmcnt(0)" ::: "memory")
#define VM_WAIT() asm volatile("s_waitcnt vmcnt(0)" ::: "memory")

__device__ __forceinline__ unsigned f2bf(float f) { unsigned u = __builtin_bit_cast(unsigned, f); return (u + 0x7fffu + ((u >> 16) & 1u)) >> 16; }
typedef __bf16 bf16x2_t __attribute__((ext_vector_type(2)));
__device__ __forceinline__ unsigned pk2(float lo, float hi) { const f32x2 v = {lo, hi}; return __builtin_bit_cast(unsigned, __builtin_convertvector(v, bf16x2_t)); }
__device__ __forceinline__ float u2f(unsigned u) { return __builtin_bit_cast(float, u); }
__device__ __forceinline__ unsigned f2u(float f) { return __builtin_bit_cast(unsigned, f); }
__device__ __forceinline__ unsigned pk4_fp8(float a, float b, float c, float d) {
    a = __builtin_amdgcn_fmed3f(a, -448.f, 448.f); b = __builtin_amdgcn_fmed3f(b, -448.f, 448.f); c = __builtin_amdgcn_fmed3f(c, -448.f, 448.f); d = __builtin_amdgcn_fmed3f(d, -448.f, 448.f);
    int p = __builtin_amdgcn_cvt_pk_fp8_f32(a, b, 0, false); p = __builtin_amdgcn_cvt_pk_fp8_f32(c, d, p, true); return (unsigned)p; }
__device__ __forceinline__ float bf_lo(unsigned w) { return __builtin_bit_cast(float, w << 16); }
__device__ __forceinline__ float bf_hi(unsigned w) { return __builtin_bit_cast(float, w & 0xffff0000u); }
__device__ __forceinline__ float fast_sigmoid(float v) { return __builtin_amdgcn_rcpf(1.0f + __expf(-v)); }
__device__ __forceinline__ float gelu_tanh(float x) { const float w = __builtin_fmaf(x * x, -0.10294324f, -2.3022082f);
    return x * __builtin_amdgcn_rcpf(1.0f + __builtin_amdgcn_exp2f(x * w)); }
__device__ __forceinline__ float shx(float v, int lane, int mask) { return __builtin_bit_cast(float, __builtin_amdgcn_ds_bpermute((lane ^ mask) << 2, __builtin_bit_cast(int, v))); }
__device__ __forceinline__ float wave_sum(float v, int lane) {
#pragma unroll
    for (int o = 1; o < 64; o <<= 1) v += shx(v, lane, o);
    return v;
}

namespace pg8 {
constexpr int BM = 256, BK = 64, HALF = 128, HTB = HALF * BK * 2, STAGE_BYTES = 8 * HTB, NXCD = 8, WGM = 8;
__host__ __device__ __forceinline__ int lds_byte(int r, int c) { const int st = (r >> 4) * 2 + (c >> 5), rr = r & 15, cc = c & 31, ob = rr * 64 + cc * 2; return st * 1024 + (ob ^ (((ob >> 9) & 1) << 5)); }
__host__ __device__ __forceinline__ void stage_rc(int b, int& R, int& C) { const int st = b / 1024, sb = b % 1024, swz = sb ^ (((sb >> 9) & 1) << 5); R = (st >> 1) * 16 + swz / 64; C = (st & 1) * 32 + (swz % 64) / 2; }
__host__ __device__ __forceinline__ int perm32(int rho) { const int n = rho >> 4, i = rho & 15; return 8 * (i >> 2) + 4 * n + (i & 3); }

struct Unit { const char* a; const char* b; const int* rows; int pm, pn, x, valid, nt; };
struct GemmP { int ldaB, ldbB, nt; };

struct Sched2D {
    static constexpr bool GATHER = false, VARNT = false;
    const char* A; const char* B; int ldaB, ldbB, nM, nN, nwg, G, c;
    __device__ __forceinline__ void init(const void* A_, const void* B_, int ldaB_, int ldbB_, int Mr, int Nc, int G_, int c_) { A = (const char*)A_; B = (const char*)B_; ldaB = ldaB_; ldbB = ldbB_; nM = Mr / BM; nN = Nc / BM; nwg = nM * nN; G = G_; c = c_; }
    __device__ __forceinline__ bool next(int i, Unit& u) const {
        const long L = (long)i * G + c; if (L >= nwg) return false;
        int wgid = (int)L; { const int q = nwg / NXCD, r = nwg % NXCD, xcd = wgid % NXCD, off = wgid / NXCD; wgid = (xcd < r ? xcd * (q + 1) : r * (q + 1) + (xcd - r) * q) + off; }
        const int nig = WGM * nN, gid = wgid / nig, fm = gid * WGM, gsz = (nM - fm) < WGM ? (nM - fm) : WGM;
        u.pm = fm + ((wgid % nig) % gsz); u.pn = (wgid % nig) / gsz; u.x = 0; u.valid = BM; u.rows = nullptr;
        u.a = A + (size_t)u.pm * BM * ldaB; u.b = B + (size_t)u.pn * BM * ldbB; return true;
    }
};
struct SchedHead {
    static constexpr bool GATHER = false, VARNT = false;
    const char* A; const char* B; size_t aStride, bStride; int ldaB, un;
    __device__ __forceinline__ bool next(int i, Unit& u) const {
        if (i > 0 || un < 0) return false;
        const int head = un >> 2, pm = un & 3;
        u.pm = pm; u.pn = 0; u.x = head; u.valid = BM; u.rows = nullptr; u.a = A + (size_t)head * aStride + (size_t)pm * BM * ldaB; u.b = B + (size_t)head * bStride; return true;
    }
};
__device__ __forceinline__ int head_unit_of(int i, int G, int c) { if (G == 256) { const int x = c & 7, idx = c >> 3; return (i == 0 && idx < 16) ? x * 16 + idx : -1; } const int un = i * G + c; return un < 128 ? un : -1; }

__device__ __forceinline__ unsigned char* kws_();
constexpr size_t WS_TILES_ = WS_TILES, WS_ROWTOK_ = WS_ROWTOK; constexpr int NASG_ = 2 * M;
constexpr int TILE_LDS_OFF = 131072 + 1024;
constexpr int SC_LDS_OFF = TILE_LDS_OFF + 4096 + 8192;
constexpr int IX_LDS_OFF = TILE_LDS_OFF + 4096;
template <bool GA> struct SchedMoe {
    static constexpr bool GATHER = GA, VARNT = !GA;
    static constexpr int KSPLIT = 4, KSL = 6;
    const char* A; const char* B; size_t bStrideE; LAS const int* tl; int ldaB, ldbB, nM, nN, nwg, G, c, nsub, ntFull;
    __device__ __forceinline__ void init(LAS unsigned char* lds, int tid, const void* A_, const void* B_, size_t bStrideE_, int ldaB_, int ldbB_, int Nc, int G_, int c_) {
        A = (const char*)A_; B = (const char*)B_; bStrideE = bStrideE_; ldaB = ldaB_; ldbB = ldbB_;
        LAS int* t = (LAS int*)(lds + TILE_LDS_OFF); const int* g = (const int*)(kws_() + WS_TILES_);
        if constexpr (GA) {
            for (int i = tid; i < 1024; i += 512) t[i] = g[i];
            asm volatile("s_waitcnt vmcnt(0) lgkmcnt(0)" ::: "memory"); __syncthreads(); }
        tl = t; nM = __builtin_amdgcn_readfirstlane(t[255 * 4]); nN = Nc / BM; G = G_; c = c_; nsub = 0; ntFull = ldaB_ / 128;
        if constexpr (!GA) { constexpr int nMain = 128;        if (nM > nMain) { nsub = __builtin_amdgcn_readfirstlane((nM - nMain) * nN * KSPLIT); nM = nMain; } }
        nwg = __builtin_amdgcn_readfirstlane(nM * nN); }
    __device__ __forceinline__ bool next(int i, Unit& u) const {
        const int L = i * G + c; size_t ko = 0; u.nt = ntFull;
        if (L >= nwg) { if (GA || L - nwg >= nsub) return false;
            const int j = L - nwg, sl = j & (KSPLIT - 1), o = j / (KSPLIT * nN); u.pn = (j / KSPLIT) % nN; u.pm = nM + o;
            u.x = NASG_ + (sl * 8 + o) * BM; ko = (size_t)(sl * KSL * 128); u.nt = sl < KSPLIT - 1 ? KSL : ntFull - (KSPLIT - 1) * KSL;
        } else {
            int wgid = L; { const int q = nwg / NXCD, r = nwg % NXCD, xcd = wgid % NXCD, off = wgid / NXCD; wgid = (xcd < r ? xcd * (q + 1) : r * (q + 1) + (xcd - r) * q) + off; }
            const int nig = WGM * nN, gid = wgid / nig, fm = gid * WGM, gsz = (nM - fm) < WGM ? (nM - fm) : WGM;
            u.pm = fm + ((wgid % nig) % gsz); u.pn = (wgid % nig) / gsz; u.x = -1; }
        const int e = __builtin_amdgcn_readfirstlane(tl[u.pm * 4]), row0 = __builtin_amdgcn_readfirstlane(tl[u.pm * 4 + 1]); u.valid = __builtin_amdgcn_readfirstlane(tl[u.pm * 4 + 2]); if (u.x < 0) u.x = row0;
        u.rows = (const int*)(kws_() + WS_ROWTOK_) + row0; u.a = GA ? A : A + (size_t)row0 * ldaB + ko; u.b = B + (size_t)e * bStrideE + (size_t)u.pn * BM * ldbB + ko; return true;
    }
};

typedef int i32x4 __attribute__((ext_vector_type(4)));
typedef int i32x8 __attribute__((ext_vector_type(8)));
template <int SX, int SY> __device__ __forceinline__ f32x4 mfma8_t(bf16x8 x0, bf16x8 x1, bf16x8 y0, bf16x8 y1, f32x4 c) {
    const i32x8 x = __builtin_shufflevector(__builtin_bit_cast(i32x4, x0), __builtin_bit_cast(i32x4, x1), 0, 1, 2, 3, 4, 5, 6, 7), y = __builtin_shufflevector(__builtin_bit_cast(i32x4, y0), __builtin_bit_cast(i32x4, y1), 0, 1, 2, 3, 4, 5, 6, 7);
    return __builtin_amdgcn_mfma_scale_f32_16x16x128_f8f6f4(x, y, c, 0, 0, 0, SX, 0, SY);
}
#define mfma8(x0, x1, y0, y1, c, sx, sy) mfma8_t<sx, sy>(x0, x1, y0, y1, c)
template <class Epi, class Sched, bool F8 = false>
__device__ __forceinline__ void gemm_phase(LAS unsigned char* lds, const GemmP g, const Sched& S, const Epi& E, int wid) {
    int lane; asm volatile("v_mbcnt_lo_u32_b32 %0, -1, 0\n\tv_mbcnt_hi_u32_b32 %0, -1, %0" : "=v"(lane));
    asm volatile("" : "+s"(wid));
    const int tid = wid * 64 + lane, wr = wid >> 2, wc = wid & 3, fr = lane & 15, fq = lane >> 4;
    constexpr bool GA = Sched::GATHER;
    unsigned vAc[2][2], vAn[2][2], voffB[2];
#pragma unroll
    for (int i = 0; i < 2; ++i) { int R, C; stage_rc(tid * 16 + i * 8192, R, C); const int Rb = Epi::PERM ? ((R & ~31) + perm32(R & 31)) : R;
        voffB[i] = (unsigned)(Rb * g.ldbB + C * 2); }
    const size_t kstep = (size_t)(BK * 2);
    const size_t hB = (size_t)HALF * g.ldbB;
    const unsigned ldsw = (unsigned)wid * 1024u;
    const int aoff = lds_byte(wr * 64 + fr, fq * 8), boff = lds_byte(wc * 32 + fr, fq * 8);
    constexpr int KOFF = 1024;
#define PG8_SA(b, h) (((b) * 2 + (h)) * HTB)
#define PG8_SB(b, h) ((4 + (b) * 2 + (h)) * HTB)
#define PG8_STAGE(bufoff, gbase, voff) do { _Pragma("unroll") for (int _i = 0; _i < 2; ++_i) { unsigned vo_ = (voff)[_i]; asm volatile("" : "+v"(vo_));     \
        __builtin_amdgcn_global_load_lds((const unsigned*)((const char*)(gbase) + vo_), (LAS unsigned*)(lds + (bufoff) + ldsw + _i * 8192), 16, 0, 0); } } while (0)
#define PG8_LDA(dst, b, h) do { _Pragma("unroll") for (int m = 0; m < 4; ++m) _Pragma("unroll") for (int k = 0; k < 2; ++k) dst[m][k] = *(const LAS bf16x8*)(lds + PG8_SA(b, h) + aoff + m * 2048 + k * KOFF); } while (0)
#define PG8_LDB(dst, b, h) do { _Pragma("unroll") for (int n = 0; n < 2; ++n) _Pragma("unroll") for (int k = 0; k < 2; ++k) dst[n][k] = *(const LAS bf16x8*)(lds + PG8_SB(b, h) + boff + n * 2048 + k * KOFF); } while (0)
#define PG8_MMA(ai, bj, At, Bt) do { __builtin_amdgcn_s_setprio(1); _Pragma("unroll") for (int m = 0; m < 4; ++m) _Pragma("unroll") for (int n = 0; n < 2; ++n) { \
        if constexpr (F8) acc[ai][bj][m][n] = mfma8(Bt[n][0], Bt[n][1], At[m][0], At[m][1], acc[ai][bj][m][n], Epi::SCALE_B, Epi::SCALE_A); \
        else { _Pragma("unroll") for (int k = 0; k < 2; ++k) acc[ai][bj][m][n] = __builtin_amdgcn_mfma_f32_16x16x32_bf16(Bt[n][k], At[m][k], acc[ai][bj][m][n], 0, 0, 0); } } __builtin_amdgcn_s_setprio(0); } while (0)
#define PG8_WAIT_V(n) asm volatile("s_waitcnt vmcnt(" #n ")" ::: "memory")
#define PG8_WAIT_L(n) asm volatile("s_waitcnt lgkmcnt(" #n ")" ::: "memory")
#define PG8_BAR __builtin_amdgcn_s_barrier()
#define PG8_SCHED __builtin_amdgcn_sched_barrier(0)
    Unit cur, nxt; int ui = 0;
    if (!S.next(0, cur)) return;
    f32x4 acc[2][2][4][2];
#pragma unroll
    for (int a = 0; a < 2; ++a)
#pragma unroll
        for (int b = 0; b < 2; ++b)
#pragma unroll
            for (int m = 0; m < 4; ++m)
#pragma unroll
                for (int n = 0; n < 2; ++n) acc[a][b][m][n] = (f32x4){0.f, 0.f, 0.f, 0.f};
    bf16x8 At[4][2], B0[2][2], B1[2][2];
    const char* cA = cur.a; const char* cB = cur.b;
    const size_t hA = GA ? (size_t)0 : (size_t)HALF * g.ldaB;
#pragma unroll
    for (int i = 0; i < 2; ++i) { int R, C; stage_rc(tid * 16 + i * 8192, R, C);
#pragma unroll
        for (int h = 0; h < 2; ++h) { const int rr = GA ? cur.rows[h * HALF + R] : R; vAc[h][i] = (unsigned)(rr * g.ldaB + C * 2); vAn[h][i] = vAc[h][i]; } }
#define PG8_STAGE_A(bufoff, gbase, h) PG8_STAGE(bufoff, (gbase) + (h) * hA, vAc[GA ? (h) : 0])
    if constexpr (GA) { Unit t1; if (S.next(1, t1)) { LAS unsigned* ix = (LAS unsigned*)(lds + IX_LDS_OFF) + tid * 4;
#pragma unroll
            for (int i = 0; i < 2; ++i) { int R, C; stage_rc(tid * 16 + i * 8192, R, C);
#pragma unroll
                for (int h = 0; h < 2; ++h) ix[h * 2 + i] = (unsigned)(t1.rows[h * HALF + R] * g.ldaB + C * 2); } } }
    float sc0_ = 0.f; if constexpr (Epi::SC) { if (wid < 4) sc0_ = E.scale_of(cur, tid); }
    PG8_STAGE(PG8_SB(0, 0), cB, voffB); PG8_STAGE(PG8_SB(0, 1), cB + hB, voffB); PG8_STAGE_A(PG8_SA(0, 0), cA, 0); PG8_STAGE_A(PG8_SA(0, 1), cA, 1);
    if (wr == 1) PG8_BAR;
    PG8_WAIT_V(2); PG8_BAR;
    PG8_STAGE(PG8_SB(1, 0), cB + kstep, voffB); PG8_STAGE_A(PG8_SA(1, 0), cA + kstep, 0); PG8_STAGE(PG8_SB(1, 1), cB + hB + kstep, voffB);
    PG8_WAIT_V(6); PG8_BAR;
    if constexpr (Epi::SC) { if (wid < 4) ((LAS float*)(lds + SC_LDS_OFF))[tid] = sc0_; }
    for (;;) {
        const bool has_next = S.next(ui + 1, nxt);
        const char* nA = has_next ? nxt.a : cA; const char* nB = has_next ? nxt.b : cB;
        if constexpr (GA) { if (has_next) {
                int l3_; asm volatile("v_mbcnt_lo_u32_b32 %0, -1, 0\n\tv_mbcnt_hi_u32_b32 %0, -1, %0" : "=v"(l3_));
                const u32x4 o4 = *((const LAS u32x4*)(lds + IX_LDS_OFF) + (wid * 64 + l3_));
                vAn[0][0] = o4.x; vAn[0][1] = o4.y; vAn[1][0] = o4.z; vAn[1][1] = o4.w; } }
        int nt = Sched::VARNT ? cur.nt : g.nt; asm volatile("" : "+s"(nt));
        for (int t = 0; t < nt; t += 2) {
            const bool last = (t == nt - 2);
            const char* a1 = cA + (size_t)(t + 1) * kstep;
            const char* a2 = last ? nA : cA + (size_t)(t + 2) * kstep; const char* b2 = last ? nB : cB + (size_t)(t + 2) * kstep;
            const char* a3 = a2 + kstep; const char* b3 = b2 + kstep;
            PG8_LDB(B0, 0, 0); PG8_LDB(B1, 0, 1); PG8_SCHED; PG8_LDA(At, 0, 0); PG8_STAGE_A(PG8_SA(1, 1), a1, 1);
            if constexpr (GA) { if (last) {
#pragma unroll
                for (int h = 0; h < 2; ++h)
#pragma unroll
                    for (int i = 0; i < 2; ++i) vAc[h][i] = vAn[h][i]; } }
            PG8_WAIT_V(8); PG8_WAIT_L(0); PG8_BAR; PG8_MMA(0, 0, At, B0); PG8_MMA(0, 1, At, B1); PG8_BAR; PG8_SCHED;
            PG8_LDA(At, 0, 1); PG8_STAGE(PG8_SB(0, 0), b2, voffB); PG8_STAGE(PG8_SB(0, 1), b2 + hB, voffB); PG8_STAGE_A(PG8_SA(0, 0), a2, 0);
            PG8_WAIT_V(8); PG8_WAIT_L(0); PG8_BAR; PG8_MMA(1, 0, At, B0); PG8_MMA(1, 1, At, B1); PG8_BAR; PG8_SCHED;
            PG8_LDB(B0, 1, 0); PG8_LDB(B1, 1, 1); PG8_SCHED; PG8_LDA(At, 1, 0); PG8_STAGE_A(PG8_SA(0, 1), a2, 1);
            PG8_WAIT_V(8); PG8_WAIT_L(0); PG8_BAR; PG8_MMA(0, 0, At, B0); PG8_MMA(0, 1, At, B1); PG8_BAR; PG8_SCHED;
            PG8_LDA(At, 1, 1); PG8_STAGE(PG8_SB(1, 0), b3, voffB); PG8_STAGE(PG8_SB(1, 1), b3 + hB, voffB); PG8_STAGE_A(PG8_SA(1, 0), a3, 0);
            PG8_WAIT_V(8); PG8_WAIT_L(0); PG8_BAR; PG8_MMA(1, 0, At, B0); PG8_MMA(1, 1, At, B1); PG8_BAR; PG8_SCHED;
        }
        if (wr == 0) PG8_BAR;
        { int ln_; asm volatile("v_mbcnt_lo_u32_b32 %0, -1, 0\n\tv_mbcnt_hi_u32_b32 %0, -1, %0" : "=v"(ln_));
          if constexpr (GA) { Unit t2; int r2[4] = {0, 0, 0, 0}; const bool has2 = has_next && S.next(ui + 2, t2);
              if (has2) { const int tid2 = wid * 64 + ln_;
#pragma unroll
                  for (int i = 0; i < 2; ++i) { int R, C; stage_rc(tid2 * 16 + i * 8192, R, C);
#pragma unroll
                      for (int h = 0; h < 2; ++h) r2[h * 2 + i] = t2.rows[h * HALF + R]; } }
              float scn_ = 0.f; if constexpr (Epi::SC) { if (has_next && wid < 4) scn_ = E.scale_of(nxt, wid * 64 + ln_); }
              E(acc, cur, wr, wc, ln_ & 15, ln_ >> 4, (LAS const float*)(lds + SC_LDS_OFF) + (ui & 1) * 256);
              if constexpr (Epi::SC) { if (has_next && wid < 4) { int l4_; asm volatile("v_mbcnt_lo_u32_b32 %0, -1, 0\n\tv_mbcnt_hi_u32_b32 %0, -1, %0" : "=v"(l4_)); ((LAS float*)(lds + SC_LDS_OFF))[((ui + 1) & 1) * 256 + wid * 64 + l4_] = scn_; } }
              if (has2) { int l2_; asm volatile("v_mbcnt_lo_u32_b32 %0, -1, 0\n\tv_mbcnt_hi_u32_b32 %0, -1, %0" : "=v"(l2_)); const int tid2 = wid * 64 + l2_; u32x4 o4;
                  { int R, C; stage_rc(tid2 * 16, R, C); o4.x = (unsigned)(r2[0] * g.ldaB + C * 2); o4.z = (unsigned)(r2[2] * g.ldaB + C * 2); }
                  { int R, C; stage_rc(tid2 * 16 + 8192, R, C); o4.y = (unsigned)(r2[1] * g.ldaB + C * 2); o4.w = (unsigned)(r2[3] * g.ldaB + C * 2); }
                  *((LAS u32x4*)(lds + IX_LDS_OFF) + tid2) = o4; } }
          else { float scn_ = 0.f; if constexpr (Epi::SC) { if (has_next && wid < 4) scn_ = E.scale_of(nxt, wid * 64 + ln_); }
              E(acc, cur, wr, wc, ln_ & 15, ln_ >> 4, (LAS const float*)(lds + SC_LDS_OFF) + (ui & 1) * 256);
              if constexpr (Epi::SC) { if (has_next && wid < 4) { int l4_; asm volatile("v_mbcnt_lo_u32_b32 %0, -1, 0\n\tv_mbcnt_hi_u32_b32 %0, -1, %0" : "=v"(l4_)); ((LAS float*)(lds + SC_LDS_OFF))[((ui + 1) & 1) * 256 + wid * 64 + l4_] = scn_; } } } }
        if (!has_next) break;
#pragma unroll
        for (int a = 0; a < 2; ++a)
#pragma unroll
            for (int b = 0; b < 2; ++b)
#pragma unroll
                for (int m = 0; m < 4; ++m)
#pragma unroll
                    for (int n = 0; n < 2; ++n) acc[a][b][m][n] = (f32x4){0.f, 0.f, 0.f, 0.f};
        cur = nxt; cA = nA; cB = nB; ++ui;
        if (wr == 1) PG8_BAR;
    }
    PG8_WAIT_V(0);
    PG8_BAR;
#undef PG8_SA
#undef PG8_SB
#undef PG8_STAGE
#undef PG8_STAGE_A
#undef PG8_LDA
#undef PG8_LDB
#undef PG8_MMA
#undef PG8_WAIT_V
#undef PG8_WAIT_L
#undef PG8_BAR
#undef PG8_SCHED
}
}

using pg8::Unit;
typedef f32x4 Acc[2][2][4][2];

__device__ __forceinline__ float stats_inv(const float* stats, int row) {
    const f32x4* p = (const f32x4*)(stats + (size_t)row * 16); const f32x4 a = p[0], b = p[1], c = p[2], d = p[3];
    const float s = (((a[0] + a[1]) + (a[2] + a[3])) + ((b[0] + b[1]) + (b[2] + b[3]))) + (((c[0] + c[1]) + (c[2] + c[3])) + ((d[0] + d[1]) + (d[2] + d[3])));
    return __builtin_amdgcn_rsqf(s * (1.0f / D) + RMS_EPS);
}
#define LOAD_SC8(inv) do { _Pragma("unroll") for (int ai_ = 0; ai_ < 2; ++ai_) _Pragma("unroll") for (int m_ = 0; m_ < 4; ++m_) inv[ai_][m_] = sc[ai_ * 128 + wr * 64 + m_ * 16 + fr]; } while (0)
__device__ __forceinline__ u32x4 pack8(const f32x4 a, const f32x4 b) { u32x4 w; w.x = pk2(a[0], a[1]); w.y = pk2(a[2], a[3]); w.z = pk2(b[0], b[1]); w.w = pk2(b[2], b[3]); return w; }

struct EpiInProj {
    static constexpr bool PERM = true, SC = true;
    const float* stats; bf16* UZ; bf16* V;
    __device__ __forceinline__ float scale_of(const Unit& u, int r) const { return stats_inv(stats, u.pm * 256 + r); }
    __device__ __forceinline__ void operator()(const Acc& acc, const Unit& u, int wr, int wc, int fr, int fq, LAS const float* sc) const {
        const int row0 = u.pm * 256 + wr * 64 + fr; float inv[2][4]; LOAD_SC8(inv);
#pragma unroll
        for (int ai = 0; ai < 2; ++ai)
#pragma unroll
            for (int m = 0; m < 4; ++m) { const int row = row0 + ai * 128 + m * 16; const float s = inv[ai][m];
#pragma unroll
                for (int bj = 0; bj < 2; ++bj) { const int c8 = u.pn * 256 + bj * 128 + wc * 32 + 8 * fq; const u32x4 w = pack8(acc[ai][bj][m][0] * s, acc[ai][bj][m][1] * s);
                    if (u.pn < 2) { const int head = c8 >> 4, g0 = c8 & 15; *(u32x4*)(UZ + ((size_t)(head * NR + (row >> 4)) * UZK + (row & 15) * 16 + g0)) = w; }
                    else *(u32x4*)(V + (size_t)row * DPOOL + (c8 - 512)) = w; } }
    }
};
struct EpiE {
    static constexpr bool PERM = false, SC = false;
    float* E;
    __device__ __forceinline__ void operator()(const Acc& acc, const Unit& u, int wr, int wc, int fr, int fq, LAS const float* sc) const {
#pragma unroll
        for (int ai = 0; ai < 2; ++ai)
#pragma unroll
            for (int m = 0; m < 4; ++m) { const int row = u.pm * 256 + ai * 128 + wr * 64 + m * 16 + fr; float* rp = E + ((size_t)(u.x * NR + row)) * 128 + wc * 32 + 4 * fq;
#pragma unroll
                for (int n = 0; n < 2; ++n) *(f32x4*)(rp + 16 * n) = acc[ai][0][m][n]; }
    }
};
struct EpiY {
    static constexpr bool PERM = true, SC = false;
    bf16* H;
    __device__ __forceinline__ void operator()(const Acc& acc, const Unit& u, int wr, int wc, int fr, int fq, LAS const float* sc) const {
#pragma unroll
        for (int ai = 0; ai < 2; ++ai)
#pragma unroll
            for (int m = 0; m < 4; ++m) { const int R = u.pm * 256 + ai * 128 + wr * 64 + m * 16 + fr;
#pragma unroll
                for (int bj = 0; bj < 2; ++bj) { const int c8 = bj * 128 + wc * 32 + 8 * fq, j = c8 >> 4, g0 = c8 & 15; f32x4 a = acc[ai][bj][m][0], b = acc[ai][bj][m][1];
#pragma unroll
                    for (int q = 0; q < 4; ++q) { a[q] = gelu_tanh(a[q]); b[q] = gelu_tanh(b[q]); }
                    *(u32x4*)(H + (size_t)(R * TC + j) * DSSM + u.x * SG + g0) = pack8(a, b); } }
    }
};
struct EpiGlu {
    static constexpr bool PERM = true, SC = false;
    const bf16* H; const float* bglu; bf16* MIXED;
    __device__ __forceinline__ void operator()(const Acc& acc, const Unit& u, int wr, int wc, int fr, int fq, LAS const float* sc) const {
#pragma unroll
        for (int bj = 0; bj < 2; ++bj) { const int c8 = u.pn * 256 + bj * 128 + wc * 32 + 8 * fq; const f32x4 b0 = *(const f32x4*)(bglu + c8) * -1.4426950408889634f, b1 = *(const f32x4*)(bglu + c8 + 4) * -1.4426950408889634f;
            u32x4 hv[2][4];
#pragma unroll
            for (int ai = 0; ai < 2; ++ai)
#pragma unroll
                for (int m = 0; m < 4; ++m) hv[ai][m] = *(const u32x4*)(H + (size_t)(u.pm * 256 + ai * 128 + wr * 64 + m * 16 + fr) * DSSM + c8);
#pragma unroll
            for (int ai = 0; ai < 2; ++ai)
#pragma unroll
                for (int m = 0; m < 4; ++m) { const int row = u.pm * 256 + ai * 128 + wr * 64 + m * 16 + fr; const u32x4 hw = hv[ai][m];
                    const f32x4 a = acc[ai][bj][m][0] + b0, b = acc[ai][bj][m][1] + b1; f32x4 oa, ob;
                    oa[0] = bf_lo(hw.x) * __builtin_amdgcn_rcpf(1.0f + __builtin_amdgcn_exp2f(a[0])); oa[1] = bf_hi(hw.x) * __builtin_amdgcn_rcpf(1.0f + __builtin_amdgcn_exp2f(a[1])); oa[2] = bf_lo(hw.y) * __builtin_amdgcn_rcpf(1.0f + __builtin_amdgcn_exp2f(a[2])); oa[3] = bf_hi(hw.y) * __builtin_amdgcn_rcpf(1.0f + __builtin_amdgcn_exp2f(a[3]));
                    ob[0] = bf_lo(hw.z) * __builtin_amdgcn_rcpf(1.0f + __builtin_amdgcn_exp2f(b[0])); ob[1] = bf_hi(hw.z) * __builtin_amdgcn_rcpf(1.0f + __builtin_amdgcn_exp2f(b[1])); ob[2] = bf_lo(hw.w) * __builtin_amdgcn_rcpf(1.0f + __builtin_amdgcn_exp2f(b[2])); ob[3] = bf_hi(hw.w) * __builtin_amdgcn_rcpf(1.0f + __builtin_amdgcn_exp2f(b[3]));
                    *(u32x4*)(MIXED + (size_t)row * D + c8) = pack8(oa, ob); } }
    }
};
struct EpiRes {
    static constexpr bool PERM = true, SC = false; static constexpr int SCALE_A = 0x7d7d7d7d, SCALE_B = 0x79797979;
    const float* srcf; bf16* XB; float* stats; unsigned char* XB8;
    __device__ __forceinline__ void operator()(const Acc& acc, const Unit& u, int wr, int wc, int fr, int fq, LAS const float* sc) const {
        const size_t off0 = (size_t)(u.pm * 256 + wr * 64 + fr) * D + u.pn * 256 + wc * 32 + 8 * fq;
        f32x4 pa[8], pb[8];
#define RES_LOAD(dstv, b) do { _Pragma("unroll") for (int mm = 0; mm < 2; ++mm) _Pragma("unroll") for (int bj = 0; bj < 2; ++bj) { \
            const size_t o_ = off0 + (size_t)(((b) >> 1) * 128 + (((b) & 1) * 2 + mm) * 16) * D + bj * 128; \
            if (srcf) { dstv[(mm * 2 + bj) * 2] = __builtin_nontemporal_load((const f32x4*)(srcf + o_)); dstv[(mm * 2 + bj) * 2 + 1] = __builtin_nontemporal_load((const f32x4*)(srcf + o_ + 4)); } \
            else { const u32x4 w_ = *(const u32x4*)(XB + o_); dstv[(mm * 2 + bj) * 2] = (f32x4){bf_lo(w_.x), bf_hi(w_.x), bf_lo(w_.y), bf_hi(w_.y)}; dstv[(mm * 2 + bj) * 2 + 1] = (f32x4){bf_lo(w_.z), bf_hi(w_.z), bf_lo(w_.w), bf_hi(w_.w)}; } } } while (0)
#define RES_DO(srcv, b) do { _Pragma("unroll") for (int mm = 0; mm < 2; ++mm) { const int ai = (b) >> 1, m = ((b) & 1) * 2 + mm; const int row = u.pm * 256 + ai * 128 + wr * 64 + m * 16 + fr; float ss = 0.f; \
            _Pragma("unroll") for (int bj = 0; bj < 2; ++bj) { const size_t o = off0 + (size_t)(ai * 128 + m * 16) * D + bj * 128; \
                const f32x4 h0 = srcv[(mm * 2 + bj) * 2] + acc[ai][bj][m][0], h1 = srcv[(mm * 2 + bj) * 2 + 1] + acc[ai][bj][m][1]; \
                *(u32x4*)(XB + o) = pack8(h0, h1); \
                if (XB8) { u32x2 w8; w8.x = pk4_fp8(h0[0], h0[1], h0[2], h0[3]); w8.y = pk4_fp8(h1[0], h1[1], h1[2], h1[3]); *(u32x2*)(XB8 + o) = w8; } \
                ss += ((h0[0] * h0[0] + h0[1] * h0[1]) + (h0[2] * h0[2] + h0[3] * h0[3])) + ((h1[0] * h1[0] + h1[1] * h1[1]) + (h1[2] * h1[2] + h1[3] * h1[3])); } \
            { const int lane = fq * 16 + fr; ss += shx(ss, lane, 16); ss += shx(ss, lane, 32); if (fq == 0) stats[(size_t)row * 16 + u.pn * 4 + wc] = ss; } } } while (0)
        RES_LOAD(pa, 0);
        RES_LOAD(pb, 1); RES_DO(pa, 0);
        RES_LOAD(pa, 2); RES_DO(pb, 1);
        RES_LOAD(pb, 3); RES_DO(pa, 2);
        RES_DO(pb, 3);
#undef RES_LOAD
#undef RES_DO
    }
};
struct EpiUp {
    static constexpr bool PERM = false, SC = true;
    const float* stats; unsigned char* HID;
    __device__ __forceinline__ float scale_of(const Unit& u, int r) const { return stats_inv(stats, u.pm * 256 + r); }
    __device__ __forceinline__ void operator()(const Acc& acc, const Unit& u, int wr, int wc, int fr, int fq, LAS const float* sc) const {
        const int row0 = u.pm * 256 + wr * 64 + fr; float inv[2][4]; LOAD_SC8(inv);
#pragma unroll
        for (int ai = 0; ai < 2; ++ai)
#pragma unroll
            for (int m = 0; m < 4; ++m) { const int row = row0 + ai * 128 + m * 16; const float s = inv[ai][m]; f32x4 o[2];
                const float s2 = s * s;
#pragma unroll
                for (int bj = 0; bj < 2; ++bj) { const f32x4 ag = acc[ai][bj][m][0], au = acc[ai][bj][m][1];
#pragma unroll
                    for (int q = 0; q < 4; ++q) o[bj][q] = ((ag[q] * au[q]) * s2) * __builtin_amdgcn_rcpf(1.0f + __builtin_amdgcn_exp2f(ag[q] * s)); }
                { u32x2 w; w.x = pk4_fp8(o[0][0], o[0][1], o[0][2], o[0][3]); w.y = pk4_fp8(o[1][0], o[1][1], o[1][2], o[1][3]); *(u32x2*)(HID + (size_t)row * DFF + u.pn * 128 + wc * 32 + 8 * fq) = w; } }
    }
};
struct EpiUpMoe {
    static constexpr bool PERM = false, SC = false; static constexpr int SCALE_A = 0x7c7c7c7c, SCALE_B = 0x79797979;
    unsigned char* HID8;
    __device__ __forceinline__ void operator()(const Acc& acc, const Unit& u, int wr, int wc, int fr, int fq, LAS const float* sc) const {
#pragma unroll
        for (int ai = 0; ai < 2; ++ai)
#pragma unroll
            for (int m = 0; m < 4; ++m) { const int rl = ai * 128 + wr * 64 + m * 16 + fr; const int row = u.x + rl; f32x4 o[2];
#pragma unroll
                for (int bj = 0; bj < 2; ++bj) { const f32x4 ag = acc[ai][bj][m][0], au = acc[ai][bj][m][1];
#pragma unroll
                    for (int q = 0; q < 4; ++q) o[bj][q] = (ag[q] * au[q]) * __builtin_amdgcn_rcpf(1.0f + __builtin_amdgcn_exp2f(ag[q])); }
                if (rl < u.valid) { u32x2 w; w.x = pk4_fp8(o[0][0], o[0][1], o[0][2], o[0][3]); w.y = pk4_fp8(o[1][0], o[1][1], o[1][2], o[1][3]); *(u32x2*)(HID8 + (size_t)row * DFF + u.pn * 128 + wc * 32 + 8 * fq) = w; } }
    }
};
struct EpiDownMoe {
    static constexpr bool PERM = true, SC = false; static constexpr int SCALE_A = 0x7d7d7d7d, SCALE_B = 0x79797979;
    bf16* Y;
    __device__ __forceinline__ void operator()(const Acc& acc, const Unit& u, int wr, int wc, int fr, int fq, LAS const float* sc) const {
#pragma unroll
        for (int ai = 0; ai < 2; ++ai)
#pragma unroll
            for (int m = 0; m < 4; ++m) { const int rl = ai * 128 + wr * 64 + m * 16 + fr; const int row = u.x + rl;
                if (rl < u.valid) {
#pragma unroll
                    for (int bj = 0; bj < 2; ++bj) *(u32x4*)(Y + (size_t)row * D + u.pn * 256 + bj * 128 + wc * 32 + 8 * fq) = pack8(acc[ai][bj][m][0], acc[ai][bj][m][1]); } }
    }
};

#define XB_TMO      128
#define XB_XCNT(j)  (256  + 64 * (j))
#define XB_XSUB(j)  (1280 + 64 * (j))
#define XB_XGEN(j)  (2304 + 64 * (j))
#define XB_TOP      3328
#define XB_TOPGEN   3392
#define XCD_BAR_WORDS 3456
#define XB_SPIN_CAP (1u << 18)
__device__ __forceinline__ unsigned xb_ld(unsigned* p)              { return __hip_atomic_load(p, __ATOMIC_RELAXED, __HIP_MEMORY_SCOPE_AGENT); }
__device__ __forceinline__ unsigned xb_add(unsigned* p, unsigned v) { return __hip_atomic_fetch_add(p, v, __ATOMIC_RELAXED, __HIP_MEMORY_SCOPE_AGENT); }
__device__ __forceinline__ unsigned xb_xcc_id() { return (unsigned)__builtin_amdgcn_s_getreg((3 << 11) | 20) & 0xFu; }
#define XB_SPIN(cond, bar) do { unsigned _sp = 0; while (cond) { __builtin_amdgcn_s_sleep(1); \
    if ((++_sp & 255u) == 0u) { if (xb_ld(&(bar)[XB_TMO])) break; if (_sp > XB_SPIN_CAP) { atomicAdd(&(bar)[XB_TMO], 1u); break; } } } } while (0)
struct XcdBarrier { unsigned* bar; unsigned x; volatile LAS unsigned* st; };
__device__ __forceinline__ XcdBarrier xcd_barrier_post(unsigned* bar, volatile LAS unsigned* st) {
    XcdBarrier b; b.bar = bar; b.x = xb_xcc_id(); b.st = st;
    if (threadIdx.x == 0) (void)xb_add(&bar[XB_XCNT(b.x)], 1u);
    return b;
}
__device__ __forceinline__ void xcd_barrier_complete(unsigned* bar, unsigned x, unsigned& nloc, unsigned& nx) {
    const unsigned G = gridDim.x * gridDim.y * gridDim.z;
    unsigned sum, cnt, mine, sp = 0u;
    for (;;) {
        sum = 0u; cnt = 0u; mine = 0u;
#pragma unroll
        for (unsigned j = 0; j < 16; ++j) { const unsigned c = xb_ld(&bar[XB_XCNT(j)]); sum += c; cnt += (c > 0u) ? 1u : 0u; mine = (j == x) ? c : mine; }
        if (sum == G) break;
        __builtin_amdgcn_s_sleep(1);
        if ((++sp & 255u) == 0u) { if (xb_ld(&bar[XB_TMO])) break; if (sp > XB_SPIN_CAP) { atomicAdd(&bar[XB_TMO], 1u); break; } }
    }
    nloc = mine > 0u ? mine : 1u; nx = cnt > 0u ? cnt : 1u;
}
__device__ __forceinline__ void xcd_barrier(const XcdBarrier& b, const bool t0  ) {
    asm volatile("s_waitcnt vmcnt(0)" ::: "memory");
    __syncthreads();
    if (t0) {
        unsigned* bar = b.bar;
        __builtin_amdgcn_s_waitcnt(0);
        __builtin_amdgcn_fence(__ATOMIC_ACQUIRE, "agent");
        unsigned nloc = b.st[0], nx = b.st[1];
        if (nloc == 0u) { xcd_barrier_complete(bar, b.x, nloc, nx); b.st[0] = nloc; b.st[1] = nx; }
        const unsigned old = xb_add(&bar[XB_XSUB(b.x)], 1u);
        const unsigned gen = old / nloc;
        if (old + 1u == (gen + 1u) * nloc) {
            __builtin_amdgcn_fence(__ATOMIC_RELEASE, "agent");
            asm volatile("s_waitcnt vmcnt(0)" ::: "memory");
            const unsigned og = xb_add(&bar[XB_TOP], 1u);
            const unsigned tg = og / nx;
            if (og + 1u == (tg + 1u) * nx) {
#pragma unroll
                for (unsigned j = 0; j < 16; ++j) xb_add(&bar[XB_XGEN(j)], 1u); }
            else XB_SPIN(xb_ld(&bar[XB_XGEN(b.x)]) == gen, bar);
            asm volatile("s_waitcnt vmcnt(0)" ::: "memory");
        } else {
            XB_SPIN(xb_ld(&bar[XB_XGEN(b.x)]) == gen, bar);
            asm volatile("s_waitcnt vmcnt(0)" ::: "memory");
        }
    }
    __syncthreads();
}

struct Ptrs {
    const float* in[25]; float* out; unsigned char* ws;
};
typedef const float* kfptr_t;
__device__ __forceinline__ const float* kin(int i) { const __attribute__((address_space(4))) kfptr_t* kp = (const __attribute__((address_space(4))) kfptr_t*)__builtin_amdgcn_kernarg_segment_ptr(); asm volatile("" : "+s"(i)); return kp[i]; }
__device__ __forceinline__ float* kout() { return (float*)kin(25); }
__device__ __forceinline__ unsigned char* kws() { return (unsigned char*)kin(26); }
__device__ __forceinline__ unsigned char* pg8::kws_() { return kws(); }
__device__ __forceinline__ int gu_row(int j, int ty) { return 256 * (j >> 7) + 128 * ((j >> 2) & 1) + 32 * ((j >> 5) & 3) + 16 * ty + 4 * ((j >> 3) & 3) + (j & 3); }

struct TrItem { const float* W; bf16* WT; const float* gk; int ldw, nblk, ldt, ty, r; float cm; };
__device__ __forceinline__ void tr_load(const TrItem& t, f32x4 (&v)[16], int lane) {
    const int kb = t.r / t.nblk, nb = t.r - kb * t.nblk;
    const float* src = t.W + (size_t)(64 * kb + (lane >> 4)) * t.ldw + 64 * nb + 4 * (lane & 15);
#pragma unroll
    for (int i = 0; i < 16; ++i) v[i] = __builtin_nontemporal_load((const f32x4*)(src + (size_t)(4 * i) * t.ldw));
}
__device__ __forceinline__ void tr_finish(const TrItem& t, const f32x4 (&v)[16], LAS float* scr, int lane) {
    const int kb = t.r / t.nblk, nb = t.r - kb * t.nblk, k0 = 64 * kb, n0 = 64 * nb;
#pragma unroll
    for (int i = 0; i < 16; ++i) { const int kk = (lane >> 4) + 4 * i; *(LAS f32x4*)(scr + kk * 64 + ((4 * (lane & 15)) ^ (8 * ((kk >> 3) & 3)))) = v[i]; }
    LDS_WAIT(); asm volatile("" ::: "memory");
    {
    const int c = lane >> 3, nl = lane & 7;
    float gs[8];
#pragma unroll
    for (int e = 0; e < 8; ++e) gs[e] = t.cm * (t.gk ? t.gk[k0 + 8 * c + e] : 1.0f);
#pragma unroll
    for (int j = 0; j < 8; ++j) { const int n = nl + 8 * j; const LAS float* sp = scr + (8 * c) * 64 + (n ^ (8 * (c & 3)));
        u32x4 o; o.x = pk2(sp[0 * 64] * gs[0], sp[1 * 64] * gs[1]); o.y = pk2(sp[2 * 64] * gs[2], sp[3 * 64] * gs[3]); o.z = pk2(sp[4 * 64] * gs[4], sp[5 * 64] * gs[5]); o.w = pk2(sp[6 * 64] * gs[6], sp[7 * 64] * gs[7]);
        const int dr = t.ty < 0 ? (n0 + n) : gu_row(n0 + n, t.ty);
        *(u32x4*)(t.WT + (size_t)dr * t.ldt + k0 + 8 * c) = o; }
    }
    LDS_WAIT(); asm volatile("" ::: "memory");
}
__device__ __forceinline__ TrItem pro_item(int q, unsigned char* ws) {
    TrItem t; t.cm = 1.0f;
    if (q < 896) { const int l = q / 448; int r = q - l * 448;
        if (r < 128) { t.W = kin(2) + (size_t)l * D * D; t.ldw = D; t.nblk = 8; t.WT = (bf16*)(ws + WS_WIN) + (size_t)l * D * D; t.ldt = D; t.gk = kin(1) + l * D; t.ty = -1; t.r = r; return t; } r -= 128;
        if (r < 64) { t.W = kin(11) + (size_t)l * 512 * 512; t.ldw = 512; t.nblk = 8; t.WT = (bf16*)(ws + WS_WGLU) + (size_t)l * 512 * 512; t.ldt = 512; t.gk = nullptr; t.ty = -1; t.r = r; t.cm = -1.4426950408889634f; return t; } r -= 64;
        t.W = kin(15) + (size_t)l * D * D; t.ldw = D; t.nblk = 16; t.WT = (bf16*)(ws + WS_WOUT) + (size_t)l * D * D; t.ldt = D; t.gk = nullptr; t.ty = -1; t.r = r; return t; }
    const int qq = q - 896, mi = qq / 704; t.r = qq - mi * 704;
    if (mi == 2) { t.W = kin(19); t.ldw = D; t.nblk = 16; t.WT = (bf16*)(ws + WS_WD); t.ldt = DFF; t.gk = nullptr; t.ty = -1; }
    else { t.W = mi == 0 ? kin(17) : kin(18); t.ldw = DFF; t.nblk = 44; t.WT = (bf16*)(ws + WS_WGU); t.ldt = D; t.gk = kin(16); t.ty = mi; t.cm = mi == 0 ? -1.4426950408889634f : -2.772588722239781f; }
    return t;
}
__device__ __forceinline__ void tr_run(unsigned char* ws, LAS float* scr, int first, int step, int it1, int lane) {
    int it = first; if (it >= it1) return;
    TrItem cur = pro_item(it, ws); f32x4 vc[16]; tr_load(cur, vc, lane);
    for (;;) { const int nx = it + step; const bool more = nx < it1; TrItem nxt = cur; f32x4 vn[16];
        if (more) { nxt = pro_item(nx, ws); tr_load(nxt, vn, lane); }
        tr_finish(cur, vc, scr, lane);
        if (!more) break;
        cur = nxt; it = nx;
#pragma unroll
        for (int i = 0; i < 16; ++i) vc[i] = vn[i]; }
}

__device__ __forceinline__ void ssm_tables_item(int item, LAS unsigned char* lds, int tid) {
    const int lh = item >> 2, q = item & 3;
    LAS float* lp_re = (LAS float*)lds;
    LAS float* lp_im = lp_re + 17 * 64;
    LAS float* cf_re = lp_im + 17 * 64;
    LAS float* cf_im = cf_re + 64;
    LAS float* bb_re = cf_im + 64;
    LAS float* bb_im = bb_re + 1024;
    LAS float* Kt = bb_im + 1024;
    LAS float* cq_re = Kt + 1024;
    LAS float* cq_im = cq_re + 256;
    const float dt = expf(kin(3)[lh]);
    const float* a_re = kin(4) + (size_t)lh * 64; const float* a_im = kin(5) + (size_t)lh * 64;
    const float* b_re = kin(6) + (size_t)lh * 1024; const float* b_im = kin(7) + (size_t)lh * 1024;
    const float* c_re = kin(8) + (size_t)lh * 1024 + q * 256; const float* c_im = kin(9) + (size_t)lh * 1024 + q * 256;
    const float* dd = kin(10) + (size_t)lh * 16;
    bf16* TW = (bf16*)(kws() + WS_TW) + (size_t)lh * 256 * UZK;
    bf16* WE = (bf16*)(kws() + WS_WE) + (size_t)lh * 256 * 256;
    float* LT = (float*)(kws() + WS_LAMT) + (size_t)lh * 128;
    __syncthreads();
    for (int idx = tid; idx < 17 * 64; idx += 512) {
        const int k = idx >> 6, p = idx & 63;
        const float ar = fminf(a_re[p], -1e-4f), ai = a_im[p];
        const float mag = expf(ar * dt * (float)k);
        double rev = (double)ai * (double)dt * (double)k * 0.15915494309189535; rev -= floor(rev);
        const float ang = (float)(rev * 6.283185307179586);
        const float sn = sinf(ang), cs = cosf(ang);
        lp_re[idx] = mag * cs; lp_im[idx] = mag * sn;
        if (k == 1) { const float lr = mag * cs, li = mag * sn, den = ar * ar + ai * ai, nr = lr - 1.0f, ni = li;
            cf_re[p] = (nr * ar + ni * ai) / den; cf_im[p] = (ni * ar - nr * ai) / den; }
        if (k == 16 && q == 0) { LT[2 * p] = mag * cs; LT[2 * p + 1] = mag * sn; }
    }
    if (tid < 256) { cq_re[tid] = c_re[tid]; cq_im[tid] = c_im[tid]; }
    __syncthreads();
    for (int idx = tid; idx < 1024; idx += 512) { const int p = idx >> 4; const float br = b_re[idx], bi = b_im[idx], cr = cf_re[p], ci = cf_im[p];
        bb_re[idx] = cr * br - ci * bi; bb_im[idx] = cr * bi + ci * br; }
    __syncthreads();
    if (tid < 256) { const int k = tid >> 4, gl = (tid >> 2) & 3, g4 = tid & 3; f32x4 s = (f32x4){0.f, 0.f, 0.f, 0.f};
#pragma unroll 2
        for (int p0 = 0; p0 < 64; p0 += 4) { const f32x4 cr4 = *(const LAS f32x4*)(cq_re + gl * 64 + p0), ci4 = *(const LAS f32x4*)(cq_im + gl * 64 + p0), wr4 = *(const LAS f32x4*)(lp_re + k * 64 + p0), wi4 = *(const LAS f32x4*)(lp_im + k * 64 + p0);
#pragma unroll
            for (int j = 0; j < 4; ++j) { const float xr = cr4[j] * wr4[j] - ci4[j] * wi4[j], xi = cr4[j] * wi4[j] + ci4[j] * wr4[j];
                const f32x4 br = *(const LAS f32x4*)(bb_re + (p0 + j) * 16 + 4 * g4), bi = *(const LAS f32x4*)(bb_im + (p0 + j) * 16 + 4 * g4); s += xr * br - xi * bi; } }
        if (k == 0 && ((4 * q + gl) >> 2) == g4) s[(4 * q + gl) & 3] += dd[4 * q + gl];
        *(LAS f32x4*)(Kt + k * 64 + gl * 16 + 4 * g4) = s; }
    __syncthreads();
    for (int ch = tid; ch < 64 * 48; ch += 512) { const int nr = ch / 48, cc = ch - nr * 48, j = nr >> 2, gl = nr & 3, n = j * 16 + 4 * q + gl, col8 = cc * 8; float v[8];
        if (col8 < 256) { const int i = col8 >> 4, gi0 = col8 & 15;
#pragma unroll
            for (int e = 0; e < 8; ++e) v[e] = (i <= j) ? Kt[((j - i) * 4 + gl) * 16 + gi0 + e] : 0.f; }
        else {
#pragma unroll
            for (int e = 0; e < 8; ++e) { const int pp = col8 - 256 + e, p = pp & 63; const float cr = cq_re[gl * 64 + p], ci = cq_im[gl * 64 + p], wr_ = lp_re[(j + 1) * 64 + p], wi = lp_im[(j + 1) * 64 + p];
                v[e] = pp < 64 ? (cr * wr_ - ci * wi) : -(cr * wi + ci * wr_); } }
        u32x4 o; o.x = pk2(v[0], v[1]); o.y = pk2(v[2], v[3]); o.z = pk2(v[4], v[5]); o.w = pk2(v[6], v[7]);
        *(u32x4*)(TW + (size_t)n * UZK + col8) = o; }
    for (int ch = tid; ch < 32 * 32; ch += 512) { const int pr = 32 * q + (ch >> 5), cc = ch & 31, col8 = cc * 8, i = col8 >> 4, g0 = col8 & 15, p = pr & 63; float v[8];
        const float wr_ = lp_re[(15 - i) * 64 + p], wi = lp_im[(15 - i) * 64 + p];
#pragma unroll
        for (int e = 0; e < 8; ++e) { const float br = bb_re[p * 16 + g0 + e], bi = bb_im[p * 16 + g0 + e]; v[e] = pr < 64 ? (wr_ * br - wi * bi) : (wr_ * bi + wi * br); }
        u32x4 o; o.x = pk2(v[0], v[1]); o.y = pk2(v[2], v[3]); o.z = pk2(v[4], v[5]); o.w = pk2(v[6], v[7]);
        *(u32x4*)(WE + (size_t)pr * 256 + col8) = o; }
    __syncthreads();
}

__device__ __forceinline__ void pool_fold_item_rolled(const Ptrs& P, int it, LAS float* scr, int lane) {
    const int l = it >> 9, grp = (it >> 7) & 3, kb = (it >> 3) & 15, db = it & 7, k = 64 * kb + lane;
    const f32x4* row = (const f32x4*)(kin(2) + ((size_t)l * D + k) * D + 512 + 128 * grp);
    const float* pw = kin(13) + ((size_t)(l * 4 + grp) * 128) * 128 + 16 * db;
    f32x4 pv[8];
#pragma unroll
    for (int i = 0; i < 8; ++i) { const int i4 = lane + 64 * i; pv[i] = *(const f32x4*)(pw + (size_t)(i4 >> 2) * 128 + 4 * (i4 & 3)); }
    f32x4 cur[4];
#pragma unroll
    for (int i = 0; i < 4; ++i) cur[i] = row[i];
#pragma unroll
    for (int i = 0; i < 8; ++i) *(LAS f32x4*)(scr + 4 * (lane + 64 * i)) = pv[i];
    LDS_WAIT(); asm volatile("" ::: "memory");
    float acc[16];
#pragma unroll
    for (int d = 0; d < 16; ++d) acc[d] = 0.f;
#pragma unroll 1
    for (int g = 0; g < 8; ++g) { f32x4 nxt[4];
#pragma unroll
        for (int i = 0; i < 4; ++i) nxt[i] = row[4 * ((g + 1) & 7) + i];
#pragma unroll
        for (int i = 0; i < 4; ++i)
#pragma unroll
            for (int cc = 0; cc < 4; ++cc) { const LAS f32x4* pr = (const LAS f32x4*)(scr + (4 * (4 * g + i) + cc) * 16);
#pragma unroll
                for (int d4 = 0; d4 < 4; ++d4) { const f32x4 pq = pr[d4];
#pragma unroll
                    for (int d = 0; d < 4; ++d) acc[4 * d4 + d] += cur[i][cc] * pq[d]; }
                __builtin_amdgcn_sched_barrier(0); }
#pragma unroll
        for (int i = 0; i < 4; ++i) cur[i] = nxt[i]; }
    LDS_WAIT(); asm volatile("" ::: "memory");
    const float gk = kin(1)[l * D + k];
    bf16* WT = (bf16*)(kws() + WS_WIN) + (size_t)l * D * D;
#pragma unroll
    for (int d = 0; d < 16; ++d) { const int dl = 128 * grp + 16 * db + d; WT[(size_t)(512 + dl) * D + k] = (bf16)f2bf(acc[d] * gk * kin(14)[l * DPOOL + dl]); }
}

__device__ __forceinline__ void pool_fold_item(const Ptrs& P, int it, LAS float* scr, int lane) {
    const int l = it >> 9, grp = (it >> 7) & 3, kb = (it >> 3) & 15, db = it & 7, k = 64 * kb + lane;
    const f32x4* row = (const f32x4*)(kin(2) + ((size_t)l * D + k) * D + 512 + 128 * grp);
    const float* pw = kin(13) + ((size_t)(l * 4 + grp) * 128) * 128 + 16 * db;
    f32x4 a[32], pv[8];
#pragma unroll
    for (int i = 0; i < 8; ++i) { const int i4 = lane + 64 * i; pv[i] = *(const f32x4*)(pw + (size_t)(i4 >> 2) * 128 + 4 * (i4 & 3)); }
#pragma unroll
    for (int i = 0; i < 32; ++i) a[i] = row[i];
#pragma unroll
    for (int i = 0; i < 8; ++i) *(LAS f32x4*)(scr + 4 * (lane + 64 * i)) = pv[i];
    LDS_WAIT(); asm volatile("" ::: "memory");
    float acc[16];
#pragma unroll
    for (int d = 0; d < 16; ++d) acc[d] = 0.f;
#pragma unroll
    for (int i = 0; i < 32; ++i)
#pragma unroll
        for (int cc = 0; cc < 4; ++cc) { const LAS f32x4* pr = (const LAS f32x4*)(scr + (4 * i + cc) * 16);
#pragma unroll
            for (int d4 = 0; d4 < 4; ++d4) { const f32x4 pq = pr[d4];
#pragma unroll
                for (int d = 0; d < 4; ++d) acc[4 * d4 + d] += a[i][cc] * pq[d]; } }
    LDS_WAIT(); asm volatile("" ::: "memory");
    const float gk = kin(1)[l * D + k];
    bf16* WT = (bf16*)(kws() + WS_WIN) + (size_t)l * D * D;
#pragma unroll
    for (int d = 0; d < 16; ++d) { const int dl = 128 * grp + 16 * db + d; WT[(size_t)(512 + dl) * D + k] = (bf16)f2bf(acc[d] * gk * kin(14)[l * DPOOL + dl]); }
}

__device__ __forceinline__ void xrow_item(const float* xrow, bf16* orow, float* srow, int lane) {
    const f32x4* xr = (const f32x4*)xrow + lane; f32x4 v[4]; float s = 0.f;
#pragma unroll
    for (int j = 0; j < 4; ++j) { v[j] = xr[64 * j]; s += (v[j][0] * v[j][0] + v[j][1] * v[j][1]) + (v[j][2] * v[j][2] + v[j][3] * v[j][3]); }
    s = wave_sum(s, lane);
    u32x2* o8 = (u32x2*)orow + lane;
#pragma unroll
    for (int j = 0; j < 4; ++j) { u32x2 w; w.x = pk2(v[j][0], v[j][1]); w.y = pk2(v[j][2], v[j][3]); o8[64 * j] = w; }
    if (lane < 16) srow[lane] = lane == 0 ? s : 0.f;
}

struct Ids { int tid, lane, wave, G, bx, gw, NGW; };
__device__ __forceinline__ int hw_lane() { int l; asm volatile("v_mbcnt_lo_u32_b32 %0, -1, 0\n\tv_mbcnt_hi_u32_b32 %0, -1, %0" : "=v"(l)); return l; }
__device__ __forceinline__ Ids make_ids(int wave) {
    asm volatile("" : "+s"(wave));
    Ids I; I.lane = hw_lane(); I.wave = wave; I.tid = wave * 64 + I.lane; I.G = gridDim.x; I.bx = blockIdx.x;
    const int vcu = (I.G % 8 == 0) ? (I.bx % 8) * (I.G / 8) + I.bx / 8 : I.bx;
    I.gw = vcu * NWAVES + I.wave; I.NGW = I.G * NWAVES; return I;
}

constexpr int XT_TAB = 0, XT_OTH = 4;
__device__ __forceinline__ void p0_prologue(const Ptrs& P, LAS unsigned char* lds, int wave) {
    const Ids I = make_ids(wave); unsigned char* ws = kws();
    for (int it = I.bx; it < 128; it += I.G) ssm_tables_item(it, lds, I.tid);
    __syncthreads();
    LAS float* scr = (LAS float*)(lds + I.wave * 16384);
    if (I.G == 256) { if (I.bx < 128) { if (I.wave < 4) pool_fold_item_rolled(P, I.wave * 128 + I.bx, scr, I.lane); else if (I.wave == 4) tr_run(ws, scr, I.bx, 128, 128, I.lane); } }
    else { tr_run(ws, scr, I.gw, I.NGW, 128, I.lane); for (int it = I.gw; it < 512; it += I.NGW) pool_fold_item(P, it, scr, I.lane); }
    const bool bal = I.G == 256; const int wv = I.bx * NWAVES + I.wave, ntr = bal ? (I.bx < 128 ? XT_TAB : XT_OTH) : (M / 4 + I.NGW - 1) / I.NGW;
#define XP_TRIP(tq) (bal ? (I.bx < 128 ? wv * XT_TAB + (tq) : 1024 * XT_TAB + (wv - 1024) * XT_OTH + (tq)) : wv + (tq) * I.NGW)
#define XP_LOAD(v, trip) do { const int m0_ = 4 * (trip); _Pragma("unroll") for (int r = 0; r < 4; ++r) { const f32x4* xr = (const f32x4*)(kin(0) + (size_t)(m0_ + r) * D) + I.lane; \
        _Pragma("unroll") for (int j = 0; j < 4; ++j) v[r][j] = __builtin_nontemporal_load(xr + 64 * j); } } while (0)
#define XP_DO(v, trip) do { const int m0_ = 4 * (trip); _Pragma("unroll") for (int r = 0; r < 4; ++r) { const int m = m0_ + r; float sq = 0.f; \
        _Pragma("unroll") for (int j = 0; j < 4; ++j) sq += (v[r][j][0] * v[r][j][0] + v[r][j][1] * v[r][j][1]) + (v[r][j][2] * v[r][j][2] + v[r][j][3] * v[r][j][3]); \
        sq = wave_sum(sq, I.lane); u32x2* o8 = (u32x2*)((bf16*)(ws + WS_XB) + (size_t)m * D) + I.lane; \
        _Pragma("unroll") for (int j = 0; j < 4; ++j) { u32x2 w; w.x = pk2(v[r][j][0], v[r][j][1]); w.y = pk2(v[r][j][2], v[r][j][3]); o8[64 * j] = w; } \
        if (I.lane < 16) ((float*)(ws + WS_STATS))[(size_t)m * 16 + I.lane] = I.lane == 0 ? sq : 0.f; } } while (0)
    f32x4 va[4][4], vb[4][4];
    if (ntr > 0 && XP_TRIP(0) < M / 4) XP_LOAD(va, XP_TRIP(0));
    for (int tq = 0; tq < ntr; tq += 2) { const int t0 = XP_TRIP(tq), t1 = XP_TRIP(tq + 1), t2 = XP_TRIP(tq + 2); if (t0 >= M / 4) break;
        const bool h1 = tq + 1 < ntr && t1 < M / 4, h2 = tq + 2 < ntr && t2 < M / 4;
        if (h1) XP_LOAD(vb, t1);
        XP_DO(va, t0);
        if (!h1) break;
        if (h2) XP_LOAD(va, t2);
        XP_DO(vb, t1); }
#undef XP_TRIP
#undef XP_LOAD
#undef XP_DO
}

constexpr int MOE_TILES = 24 * 88;
struct MoeTile { const float* src; unsigned char* dst; const float* gk; int ldw, ldt, k0, n0, ty; };
__device__ __forceinline__ MoeTile moe_tile(int tile, unsigned char* ws) {
    MoeTile t;
    if (tile >= MOE_TILES) { const int r = tile - MOE_TILES, kb = r >> 2, nb = r & 3; t.ldw = D; t.src = kin(19) + (size_t)(kb * 128) * D + nb * 256; t.dst = ws + WS_WD; t.ldt = DFF; t.k0 = kb * 128; t.n0 = nb * 256; t.ty = -1; t.gk = nullptr; return t; }
    int e, kind, r; if (tile < 1408) { const int mi = tile / 88; r = tile - mi * 88; e = mi >> 1; kind = mi & 1; } else { const int d = tile - 1408; e = d / 88; r = d - e * 88; kind = 2; }
    if (kind == 2) { const int kb = r >> 2, nb = r & 3; t.ldw = D; t.src = kin(23) + (size_t)e * DFF * D + (size_t)(kb * 128) * D + nb * 256; t.dst = ws + WS_MWD + (size_t)e * D * DFF; t.ldt = DFF; t.k0 = kb * 128; t.n0 = nb * 256; t.ty = -1; t.gk = nullptr; }
    else { const int kb = r / 11, nb = r - kb * 11; t.ldw = DFF; t.src = (kind == 0 ? kin(21) : kin(22)) + (size_t)e * D * DFF + (size_t)(kb * 128) * DFF + nb * 256; t.dst = ws + WS_MWGU + (size_t)e * 2 * DFF * D; t.ldt = D; t.k0 = kb * 128; t.n0 = nb * 256; t.ty = kind; t.gk = kin(16) + D; }
    return t;
}
__device__ __forceinline__ void moe_convert_wg(LAS unsigned char* lds, int wave, int frank, int nf, int t0, int t1) {
    const Ids I = make_ids(wave); unsigned char* ws = kws(); LAS float* tl = (LAS float*)lds; const int lane = I.lane, w = I.wave;
    int tile = t0 + frank; if (tile >= t1) return;
    MoeTile cur = moe_tile(tile, ws); f32x4 v[16];
#pragma unroll
    for (int i = 0; i < 16; ++i) v[i] = __builtin_nontemporal_load((const f32x4*)(cur.src + (size_t)(16 * w + i) * cur.ldw + 4 * lane));
    for (;;) {
        __syncthreads();
#pragma unroll
        for (int i = 0; i < 16; ++i) { const int k = 16 * w + i; *(LAS f32x4*)(tl + k * 256 + ((4 * lane) ^ (4 * ((k >> 4) & 7)))) = v[i]; }
        LDS_WAIT(); __syncthreads();
        const int nx = tile + nf; const bool more = nx < t1; const MoeTile t = cur;
        if (more) { cur = moe_tile(nx, ws);
#pragma unroll
            for (int i = 0; i < 16; ++i) v[i] = __builtin_nontemporal_load((const f32x4*)(cur.src + (size_t)(16 * w + i) * cur.ldw + 4 * lane)); }
        const int c = lane & 7, nl = lane >> 3; float gs[16];
        const float cm = t.ty == 0 ? -64.f * 1.4426950408889634f : t.ty == 1 ? -64.f * 2.772588722239781f : 64.f;
#pragma unroll
        for (int e = 0; e < 16; ++e) gs[e] = cm * (t.gk ? t.gk[t.k0 + 16 * c + e] : 1.0f);
#pragma unroll
        for (int j = 0; j < 4; ++j) { const int n = 32 * w + 8 * j + nl; const LAS float* sp = tl + (16 * c) * 256 + (n ^ (4 * c));
            u32x4 o; o.x = pk4_fp8(gs[0] * sp[0 * 256], gs[1] * sp[1 * 256], gs[2] * sp[2 * 256], gs[3] * sp[3 * 256]); o.y = pk4_fp8(gs[4] * sp[4 * 256], gs[5] * sp[5 * 256], gs[6] * sp[6 * 256], gs[7] * sp[7 * 256]);
            o.z = pk4_fp8(gs[8] * sp[8 * 256], gs[9] * sp[9 * 256], gs[10] * sp[10 * 256], gs[11] * sp[11 * 256]); o.w = pk4_fp8(gs[12] * sp[12 * 256], gs[13] * sp[13 * 256], gs[14] * sp[14 * 256], gs[15] * sp[15 * 256]);
            const int dr = t.ty < 0 ? (t.n0 + n) : gu_row(t.n0 + n, t.ty);
            *(u32x4*)(t.dst + (size_t)dr * t.ldt + t.k0 + 16 * c) = o; }
        if (!more) break;
        tile = nx;
    }
    LDS_WAIT(); __syncthreads();
}

constexpr int MF_A = 256, MF_B = MF_A + 0, MF_C = MF_B + 512, MF_D = MF_C + 384;
constexpr int MT_RT = 128;
constexpr int MT_POS = 224;
constexpr int MT_TAIL = 336, MT_END = MOE_TILES - MT_TAIL;
static_assert(MF_D < MT_END && MT_END >= 1408, "filler slots");
constexpr int PRO_SPLIT = 1280;
__device__ __forceinline__ void pro_convert(LAS unsigned char* lds, int wave, int frank, int nf, int it0 = 128, int it1 = 896 + 2 * 704) {
    const Ids I = make_ids(wave); unsigned char* ws = kws(); LAS float* scr = (LAS float*)(lds + I.wave * 16384);
    tr_run(ws, scr, it0 + frank * NWAVES + I.wave, nf * NWAVES, it1, I.lane);
}
__device__ __forceinline__ void misc_fill(const Ptrs& P, LAS unsigned char* lds, int wave, int frank, int nf) {
    const Ids I = make_ids(wave);
    for (int it = 128 + frank; it < 256; it += nf) ssm_tables_item(it, lds, I.tid);
    __syncthreads();
    LAS float* scr = (LAS float*)(lds + I.wave * 16384);
    if (nf == 128) { if (I.wave < 3) pool_fold_item_rolled(P, 512 + I.wave * 128 + frank, scr, I.lane); }
    else for (int it = 512 + frank * NWAVES + I.wave; it < 1024; it += nf * NWAVES) pool_fold_item(P, it, scr, I.lane);
}

template <int W> __device__ __forceinline__ void pool_task(const bf16* VB, bf16* MIXED, int g, int run4, int lane) {
    asm volatile("" : "+v"(lane));
    const int run = 4 * run4 + (lane >> 4), c8 = 128 * g + 8 * (lane & 15), t0 = 16 * run, tin0 = t0 & (SEQ - 1);
    const bf16* vp = VB + (size_t)t0 * DPOOL + c8;
    u32x4 v[W - 1 + 16];
#pragma unroll
    for (int i = 0; i < W - 1 + 16; ++i) { const int r = i - (W - 1); v[i] = (tin0 + r >= 0) ? *(const u32x4*)(vp + (ptrdiff_t)r * DPOOL) : (u32x4){0u, 0u, 0u, 0u}; }
    float s[8];
#pragma unroll
    for (int e = 0; e < 8; ++e) s[e] = 0.f;
#pragma unroll
    for (int i = 0; i < W - 1; ++i) { s[0] += bf_lo(v[i].x); s[1] += bf_hi(v[i].x); s[2] += bf_lo(v[i].y); s[3] += bf_hi(v[i].y); s[4] += bf_lo(v[i].z); s[5] += bf_hi(v[i].z); s[6] += bf_lo(v[i].w); s[7] += bf_hi(v[i].w); }
#pragma unroll
    for (int j = 0; j < 16; ++j) { const u32x4 c = v[W - 1 + j]; const float x[8] = {bf_lo(c.x), bf_hi(c.x), bf_lo(c.y), bf_hi(c.y), bf_lo(c.z), bf_hi(c.z), bf_lo(c.w), bf_hi(c.w)};
#pragma unroll
        for (int e = 0; e < 8; ++e) s[e] += x[e];
        const int cnt = tin0 + j + 1 < W ? tin0 + j + 1 : W; const float rc = 1.0f / (float)cnt; u32x4 o;
        o.x = pk2(s[0] * rc - x[0], s[1] * rc - x[1]); o.y = pk2(s[2] * rc - x[2], s[3] * rc - x[3]); o.z = pk2(s[4] * rc - x[4], s[5] * rc - x[5]); o.w = pk2(s[6] * rc - x[6], s[7] * rc - x[7]);
        *(u32x4*)(MIXED + (size_t)(t0 + j) * D + 512 + c8) = o;
        const u32x4 d = v[j];
        s[0] -= bf_lo(d.x); s[1] -= bf_hi(d.x); s[2] -= bf_lo(d.y); s[3] -= bf_hi(d.y); s[4] -= bf_lo(d.z); s[5] -= bf_hi(d.z); s[6] -= bf_lo(d.w); s[7] -= bf_hi(d.w); }
}
__device__ __forceinline__ void pool_filter(int wave, int prank, int pn) {
    const Ids I = make_ids(wave); const bf16* VB = (const bf16*)(kws() + WS_V); bf16* MIXED = (bf16*)(kws() + WS_MIXED);
    for (int task = prank * NWAVES + I.wave; task < 4 * (M / 64); task += pn * NWAVES) { const int g = task & 3, run4 = task >> 2;
        if (g == 0) pool_task<2>(VB, MIXED, 0, run4, I.lane); else if (g == 1) pool_task<4>(VB, MIXED, 1, run4, I.lane);
        else if (g == 2) pool_task<8>(VB, MIXED, 2, run4, I.lane); else pool_task<16>(VB, MIXED, 3, run4, I.lane); }
}

__device__ __forceinline__ void scan_unit(int l, int un, LAS unsigned char* lds, int wave) {
    const Ids I = make_ids(wave); const int lane = I.lane, h = un >> 2, pm = un & 3, bb = I.wave >> 2, sg = I.wave & 3;
    const float* LT = (const float*)(kws() + WS_LAMT) + (size_t)(l * NH + h) * 128; const float ltr = LT[2 * lane], lti = LT[2 * lane + 1];
    const size_t row0 = (size_t)h * NR + pm * 256 + bb * 128 + sg * 32;
    const float* eb = (const float*)(kws() + WS_E) + row0 * 128; bf16* zb = (bf16*)(kws() + WS_UZ) + row0 * UZK + 256;
    LAS float* xch = (LAS float*)lds;
    float zr[32], zi[32], er = 0.f, ei = 0.f;
    {   float a[32], b[32];
#pragma unroll
        for (int i = 0; i < 32; ++i) { a[i] = __builtin_nontemporal_load(eb + (size_t)i * 128 + lane); b[i] = __builtin_nontemporal_load(eb + (size_t)i * 128 + 64 + lane); }
#pragma unroll
        for (int i = 0; i < 32; ++i) { zr[i] = er; zi[i] = ei; const float nr = ltr * er - lti * ei + a[i], ni = ltr * ei + lti * er + b[i]; er = nr; ei = ni; } }
    xch[I.wave * 128 + lane] = er; xch[I.wave * 128 + 64 + lane] = ei;
    float pr = ltr, pi = lti;
#pragma unroll
    for (int q = 0; q < 5; ++q) { const float nr = pr * pr - pi * pi, ni = 2.f * pr * pi; pr = nr; pi = ni; }
    LDS_WAIT(); __syncthreads();
    float cr = 0.f, ci = 0.f;
    for (int s2 = 0; s2 < sg; ++s2) { const float xr = xch[(bb * 4 + s2) * 128 + lane], xi = xch[(bb * 4 + s2) * 128 + 64 + lane]; const float nr = pr * cr - pi * ci + xr, ni = pr * ci + pi * cr + xi; cr = nr; ci = ni; }
    float wr_ = 1.f, wi = 0.f;
#pragma unroll
    for (int i = 0; i < 32; ++i) { const float fr = zr[i] + wr_ * cr - wi * ci, fi = zi[i] + wr_ * ci + wi * cr;
        zb[(size_t)i * UZK + lane] = (bf16)f2bf(fr); zb[(size_t)i * UZK + 64 + lane] = (bf16)f2bf(fi);
        const float nr = wr_ * ltr - wi * lti, ni = wr_ * lti + wi * ltr; wr_ = nr; wi = ni; }
    LDS_WAIT(); __syncthreads();
}
__device__ __forceinline__ void wg_publish_local(bool t0, bool inv) {
    asm volatile("s_waitcnt vmcnt(0)" ::: "memory"); __syncthreads();
    if (inv) { if (t0) { __builtin_amdgcn_fence(__ATOMIC_ACQUIRE, "agent"); asm volatile("s_waitcnt vmcnt(0)" ::: "memory"); }
               __syncthreads(); }
}

constexpr int RT_LD = 2064;
__device__ __forceinline__ void routing_phase(const Ptrs& P, LAS unsigned char* lds, int wave, const bool packed = false  ) {
    const Ids I = make_ids(wave); const int lane = I.lane, fr = lane & 15, fq = lane >> 4; unsigned char* ws = kws();
    u32x4* TOK = (u32x4*)(ws + WS_TOK); int* CNT = (int*)(ws + WS_CNT); LAS int* lcnt = (LAS int*)(lds + 16 * RT_LD);
    const bool act = packed || I.wave < 4; const int g0_ = packed ? 2 * I.bx : I.bx;
    for (int grp0 = g0_; grp0 < M / 64; grp0 += packed ? M / 64 : I.G) { const int grp = grp0 + (packed ? (I.wave >> 2) : 0);
        bf16x8 a[32];
        const int m = 64 * grp + 16 * (I.wave & 3) + fr;
        if (act) { const bf16x8* xr = (const bf16x8*)((const bf16*)(ws + WS_XB) + (size_t)m * D + 256 * fq);
#pragma unroll
            for (int s_ = 0; s_ < 32; ++s_) a[s_] = xr[s_]; }
        if (grp0 == g0_) {
            float wv[2][8], gkv[2];
#pragma unroll
            for (int h = 0; h < 2; ++h) { const int k = I.tid + 512 * h; const f32x4 r0 = *(const f32x4*)(kin(20) + (size_t)k * 8), r1 = *(const f32x4*)(kin(20) + (size_t)k * 8 + 4); gkv[h] = kin(16)[D + k];
#pragma unroll
                for (int e = 0; e < 4; ++e) { wv[h][e] = r0[e]; wv[h][4 + e] = r1[e]; } }
#pragma unroll
            for (int h = 0; h < 2; ++h) { const int k = I.tid + 512 * h;
#pragma unroll
                for (int e = 0; e < 8; ++e) { const float w = gkv[h] * wv[h][e]; const unsigned hi = f2bf(w); const float rest = w - u2f(hi << 16);
                    *(LAS unsigned short*)(lds + e * RT_LD + 2 * k) = (unsigned short)hi; *(LAS unsigned short*)(lds + (8 + e) * RT_LD + 2 * k) = (unsigned short)f2bf(rest); } }
        }
        LDS_WAIT(); __syncthreads();
        if (act) {
            f32x4 acc = (f32x4){0.f, 0.f, 0.f, 0.f}, sq = (f32x4){0.f, 0.f, 0.f, 0.f};
            const LAS unsigned char* bp = lds + fr * RT_LD + 512 * fq;
#pragma unroll
            for (int s_ = 0; s_ < 32; ++s_) { const bf16x8 b = *(const LAS bf16x8*)(bp + 16 * s_);
                acc = __builtin_amdgcn_mfma_f32_16x16x32_bf16(b, a[s_], acc, 0, 0, 0); sq = __builtin_amdgcn_mfma_f32_16x16x32_bf16(a[s_], a[s_], sq, 0, 0, 0); }
            float ssd = (fr & 3) == 0 ? sq[0] : (fr & 3) == 1 ? sq[1] : (fr & 3) == 2 ? sq[2] : sq[3];
            const float ss = __builtin_bit_cast(float, __builtin_amdgcn_ds_bpermute((fr + 16 * (fr >> 2)) << 2, __builtin_bit_cast(int, ssd)));
            const float inv = 1.0f / sqrtf(ss * (1.0f / D) + RMS_EPS);
            float pl[4];
#pragma unroll
            for (int q = 0; q < 4; ++q) pl[q] = (acc[q] + shx(acc[q], lane, 32)) * inv;
            const int eb = 4 * (fq & 1); float v0 = pl[0], v1 = -3.0e38f; int e0 = eb, e1 = -1;
#pragma unroll
            for (int q = 1; q < 4; ++q) { const float v = pl[q]; const int e = eb + q;
                if (v > v0) { v1 = v0; e1 = e0; v0 = v; e0 = e; } else if (v > v1) { v1 = v; e1 = e; } }
            { const float ov0 = shx(v0, lane, 16), ov1 = shx(v1, lane, 16); const int oe0 = __builtin_amdgcn_ds_bpermute((lane ^ 16) << 2, e0), oe1 = __builtin_amdgcn_ds_bpermute((lane ^ 16) << 2, e1);
              const bool ofirst = ov0 > v0 || (ov0 == v0 && oe0 < e0);
              const float w0 = ofirst ? ov0 : v0; const int f0 = ofirst ? oe0 : e0;
              const float c1 = ofirst ? v0 : ov0; const int d1 = ofirst ? e0 : oe0;
              const float c2 = ofirst ? ov1 : v1; const int d2 = ofirst ? oe1 : e1;
              const bool s2 = c2 > c1 || (c2 == c1 && d2 < d1);
              v0 = w0; e0 = f0; v1 = s2 ? c2 : c1; e1 = s2 ? d2 : d1; }
            { unsigned char* x8 = ws + WS_XB8 + (size_t)m * D + 256 * fq; const float sc8 = 8.0f * inv;
#pragma unroll
              for (int s_ = 0; s_ < 32; s_ += 2) { const u32x4 w0 = __builtin_bit_cast(u32x4, a[s_]), w1 = __builtin_bit_cast(u32x4, a[s_ + 1]); u32x4 o8;
                  o8.x = pk4_fp8(sc8 * bf_lo(w0.x), sc8 * bf_hi(w0.x), sc8 * bf_lo(w0.y), sc8 * bf_hi(w0.y)); o8.y = pk4_fp8(sc8 * bf_lo(w0.z), sc8 * bf_hi(w0.z), sc8 * bf_lo(w0.w), sc8 * bf_hi(w0.w));
                  o8.z = pk4_fp8(sc8 * bf_lo(w1.x), sc8 * bf_hi(w1.x), sc8 * bf_lo(w1.y), sc8 * bf_hi(w1.y)); o8.w = pk4_fp8(sc8 * bf_lo(w1.z), sc8 * bf_hi(w1.z), sc8 * bf_lo(w1.w), sc8 * bf_hi(w1.w));
                  *(u32x4*)(x8 + 8 * s_) = o8; } }
            const float x1 = expf(v1 - v0), g0 = 1.0f / (1.0f + x1), g1 = x1 * g0;
            if (fq == 0) { u32x4 t; t.x = (unsigned)e0 | ((unsigned)e1 << 8); t.y = f2u(g0); t.z = f2u(g1); t.w = f2u(inv); TOK[m] = t; }
            int mine = 0;
#pragma unroll
            for (int e = 0; e < 8; ++e) { const int c = __popcll(__ballot(fq == 0 && e0 == e)) + __popcll(__ballot(fq == 0 && e1 == e)); mine = lane == e ? c : mine; }
            if (lane < 8) lcnt[I.wave * 8 + lane] = mine;
        }
        LDS_WAIT(); __syncthreads();
        if (I.tid < (packed ? 16 : 8)) { const int h_ = I.tid >> 3, e_ = I.tid & 7; LAS const int* lc = lcnt + h_ * 32 + e_; CNT[(grp0 + h_) * 8 + e_] = (lc[0] + lc[8]) + (lc[16] + lc[24]); }
        __syncthreads();
    }
}

__device__ __forceinline__ int isum(int v, int lane) {
#pragma unroll
    for (int o = 1; o < 64; o <<= 1) v += __builtin_amdgcn_ds_bpermute((lane ^ o) << 2, v);
    return v;
}
__device__ __forceinline__ void pos_phase(const Ptrs& P, int wave, const bool packed = false  ) {
    const Ids I = make_ids(wave); if (!packed && I.wave != 0) return;
    const int lane = I.lane; unsigned char* ws = kws();
    const u32x4* TOK = (const u32x4*)(ws + WS_TOK); const int* CNT = (const int*)(ws + WS_CNT); int* POS = (int*)(ws + WS_POS); int* ROWTOK = (int*)(ws + WS_ROWTOK); float* ROWINV = (float*)(ws + WS_ROWINV); int* TILES = (int*)(ws + WS_TILES);
    const int vcu = packed ? I.bx * NWAVES + I.wave : I.gw >> 3, vstep = packed ? M / 64 : I.G;
    for (int grp = vcu; grp < M / 64; grp += vstep) {
        int tot[8], pre[8];
#pragma unroll
        for (int e = 0; e < 8; ++e) { tot[e] = 0; pre[e] = 0; }
#pragma unroll
        for (int q = 0; q < 4; ++q) { const int r = lane + 64 * q; const int4 c0 = *(const int4*)(CNT + r * 8), c1 = *(const int4*)(CNT + r * 8 + 4); const int cc[8] = {c0.x, c0.y, c0.z, c0.w, c1.x, c1.y, c1.z, c1.w};
#pragma unroll
            for (int e = 0; e < 8; ++e) { tot[e] += cc[e]; pre[e] += r < grp ? cc[e] : 0; } }
        int off[8], run = 0;
#pragma unroll
        for (int e = 0; e < 8; ++e) { tot[e] = isum(tot[e], lane); pre[e] = isum(pre[e], lane); off[e] = run; run += tot[e]; }
        const int m = 64 * grp + lane; const u32x4 t = TOK[m]; const int e0 = t.x & 0xff, e1 = (t.x >> 8) & 0xff;
        const unsigned long long lt = (1ull << lane) - 1ull; int p0 = 0, p1 = 0; unsigned f0 = 0u, f1 = 0u;
        int pidx = 0;
#pragma unroll
        for (int e = 0; e < 8; ++e) pidx += tot[e] >> 8;
#pragma unroll
        for (int e = 0; e < 8; ++e) { const unsigned long long mk = __ballot(e0 == e || e1 == e); const int k = pre[e] + __popcll(mk & lt), r = off[e] + k;
            const int fullr = tot[e] & ~255; const bool hasp = (tot[e] & 255) != 0;
            const unsigned fl = (hasp && pidx >= 128 && k >= fullr) ? (0x80000000u | ((unsigned)((pidx - 128) * 256 + (k & 255)) << 16)) : 0u;
            p0 = e0 == e ? r : p0; p1 = e1 == e ? r : p1; f0 = e0 == e ? fl : f0; f1 = e1 == e ? fl : f1; pidx += hasp ? 1 : 0; }
        POS[2 * m] = (int)((unsigned)p0 | f0); POS[2 * m + 1] = (int)((unsigned)p1 | f1); ROWTOK[p0] = m; ROWTOK[p1] = m; const unsigned tw = t.w; ROWINV[p0] = u2f(tw); ROWINV[p1] = u2f(tw);
        if (grp == 0) {
#pragma unroll
            for (int q = 0; q < 4; ++q) ROWTOK[NASG + lane + 64 * q] = 0;
            if (lane == 0) { int nt = 0;
                for (int e = 0; e < 8; ++e) for (int k = 0; 256 * (k + 1) <= tot[e]; ++k) { *(int4*)(TILES + 4 * nt) = make_int4(e, off[e] + 256 * k, 256, 0); ++nt; }
                for (int e = 0; e < 8; ++e) if (tot[e] & 255) { *(int4*)(TILES + 4 * nt) = make_int4(e, off[e] + (tot[e] & ~255), tot[e] & 255, 0); ++nt; }
                TILES[255 * 4] = nt; }
        }
    }
}

__device__ __forceinline__ void final_phase(const Ptrs& P, int wave) {
    const Ids I = make_ids(wave); const int lane = I.lane; unsigned char* ws = kws();
    const u32x4* TOK = (const u32x4*)(ws + WS_TOK); const int* POS = (const int*)(ws + WS_POS); const bf16* Y = (const bf16*)(ws + WS_Y);
    const f32x4* gf = (const f32x4*)kin(24) + lane; f32x4 gv[4];
#pragma unroll
    for (int j = 0; j < 4; ++j) gv[j] = gf[64 * j];
    const bool poison = xb_ld((unsigned*)(ws + WS_CTL) + CW_BAR + XB_TMO) != 0u;
    for (int m = I.gw; m < M; m += I.NGW) { f32x4* xr = (f32x4*)(kout() + (size_t)m * D) + lane; const u32x2* hr = (const u32x2*)((const bf16*)(ws + WS_XB) + (size_t)m * D) + lane; f32x4 v[4]; float ss = 0.f;
        const u32x4 t = TOK[m]; const unsigned ty = t.y, tz = t.z; const float g0 = u2f(ty), g1 = u2f(tz); const unsigned q0 = (unsigned)__builtin_amdgcn_readfirstlane(POS[2 * m]), q1 = (unsigned)__builtin_amdgcn_readfirstlane(POS[2 * m + 1]);
        const bool s0 = (q0 >> 31) != 0u, s1 = (q1 >> 31) != 0u; const int p0 = s0 ? NASG + (int)((q0 >> 16) & 0x7fffu) : (int)(q0 & 0xffffu), p1 = s1 ? NASG + (int)((q1 >> 16) & 0x7fffu) : (int)(q1 & 0xffffu);
        const u32x2* y0 = (const u32x2*)(Y + (size_t)p0 * D) + lane; const u32x2* y1 = (const u32x2*)(Y + (size_t)p1 * D) + lane;
        u32x2 hw[4], ya_[4], yb_[4];
#pragma unroll
        for (int j = 0; j < 4; ++j) { hw[j] = hr[64 * j]; ya_[j] = y0[64 * j]; yb_[j] = y1[64 * j]; }
        f32x4 ya[4], yb[4];
#pragma unroll
        for (int j = 0; j < 4; ++j) { ya[j] = (f32x4){bf_lo(ya_[j].x), bf_hi(ya_[j].x), bf_lo(ya_[j].y), bf_hi(ya_[j].y)}; yb[j] = (f32x4){bf_lo(yb_[j].x), bf_hi(yb_[j].x), bf_lo(yb_[j].y), bf_hi(yb_[j].y)}; }
        if (s0 || s1) {
#pragma unroll
            for (int sl = 1; sl < 4; ++sl)
#pragma unroll
                for (int j = 0; j < 4; ++j) {
                    if (s0) { const u32x2 c = y0[64 * j + sl * (2048 * D / 4)]; ya[j] += (f32x4){bf_lo(c.x), bf_hi(c.x), bf_lo(c.y), bf_hi(c.y)}; }
                    if (s1) { const u32x2 c = y1[64 * j + sl * (2048 * D / 4)]; yb[j] += (f32x4){bf_lo(c.x), bf_hi(c.x), bf_lo(c.y), bf_hi(c.y)}; } } }
#pragma unroll
        for (int j = 0; j < 4; ++j) { v[j] = (f32x4){bf_lo(hw[j].x), bf_hi(hw[j].x), bf_lo(hw[j].y), bf_hi(hw[j].y)};
            v[j][0] += g0 * ya[j][0] + g1 * yb[j][0]; v[j][1] += g0 * ya[j][1] + g1 * yb[j][1]; v[j][2] += g0 * ya[j][2] + g1 * yb[j][2]; v[j][3] += g0 * ya[j][3] + g1 * yb[j][3];
            ss += (v[j][0] * v[j][0] + v[j][1] * v[j][1]) + (v[j][2] * v[j][2] + v[j][3] * v[j][3]); }
        ss = wave_sum(ss, lane); float inv = 1.0f / sqrtf(ss * (1.0f / D) + RMS_EPS); if (poison) inv = __builtin_nanf("");
#pragma unroll
        for (int j = 0; j < 4; ++j) xr[64 * j] = v[j] * inv * gv[j]; }
}

__global__ void __launch_bounds__(NWAVES * 64, 2) trunk_fwd(Ptrs P) {
    extern __shared__ __attribute__((aligned(16))) unsigned char lds_raw[];
    LAS unsigned char* lds = (LAS unsigned char*)lds_raw;
    volatile LAS unsigned* MISC = (volatile LAS unsigned*)(lds + MISC_OFF);
#define OPQ_GB int G = gridDim.x, bx = blockIdx.x; asm volatile("" : "+s"(G), "+s"(bx))
    const int wave0 = __builtin_amdgcn_readfirstlane((int)threadIdx.x >> 6);
    for (int u = threadIdx.x; u < (LDS_BYTES - LDSCTL_OFF) / 4; u += NWAVES * 64) ((LAS unsigned*)(lds + LDSCTL_OFF))[u] = 0u;
    __syncthreads();
    XcdBarrier bar = xcd_barrier_post((unsigned*)(kws() + WS_CTL) + CW_BAR, MISC + 8);
#define GRID_BAR() do { XcdBarrier b_ = bar; asm volatile("" : "+s"(b_.x)); xcd_barrier(b_, wave0 == 0 && hw_lane() == 0); } while (0)

    p0_prologue(P, lds, wave0);
    GRID_BAR();

    for (int l = 0; l < 2; ++l) {
        { unsigned char* ws = kws(); OPQ_GB; pg8::Sched2D S; S.init(ws + WS_XB, (bf16*)(ws + WS_WIN) + (size_t)l * D * D, D * 2, D * 2, M, D, G, bx);
          EpiInProj E{(const float*)(ws + WS_STATS), (bf16*)(ws + WS_UZ), (bf16*)(ws + WS_V)}; pg8::gemm_phase(lds, pg8::GemmP{D * 2, D * 2, D / 64}, S, E, wave0); }
        GRID_BAR();
        { unsigned char* ws = kws(); OPQ_GB;
          if (G == 256 && (bx >> 3) >= 16) {
              const int fr = (bx & 7) * 16 + ((bx >> 3) - 16); pool_filter(wave0, fr, 128);
              if (l == 0) { pro_convert(lds, wave0, fr, 128, 128, PRO_SPLIT); moe_convert_wg(lds, wave0, fr, 128, MOE_TILES, MOE_TILES + 88); }
              moe_convert_wg(lds, wave0, fr, 128, l == 0 ? 0 : MF_C, l == 0 ? MF_A : MF_D);
          } else {
              for (int i = 0;; ++i) { const int un = pg8::head_unit_of(i, G, bx); if (un < 0) break;
                  { pg8::SchedHead S{(const char*)(ws + WS_UZ), (const char*)((bf16*)(ws + WS_WE) + (size_t)l * NH * 256 * 256), (size_t)NR * UZK * 2, (size_t)256 * 256 * 2, UZK * 2, un};
                    EpiE E{(float*)(ws + WS_E)}; pg8::gemm_phase(lds, pg8::GemmP{UZK * 2, 256 * 2, 4}, S, E, wave0); }
                  wg_publish_local(wave0 == 0 && hw_lane() == 0, false);
                  scan_unit(l, un, lds, wave0);
                  wg_publish_local(wave0 == 0 && hw_lane() == 0, false);
                  { pg8::SchedHead S{(const char*)(ws + WS_UZ), (const char*)((bf16*)(ws + WS_TW) + (size_t)l * NH * 256 * UZK), (size_t)NR * UZK * 2, (size_t)256 * UZK * 2, UZK * 2, un};
                    EpiY E{(bf16*)(ws + WS_H)}; pg8::gemm_phase(lds, pg8::GemmP{UZK * 2, UZK * 2, UZK / 64}, S, E, wave0); } }
              if (G == 256 && l == 0) pro_convert(lds, wave0, (bx & 7) * 16 + (bx >> 3), 128, PRO_SPLIT, 896 + 2 * 704);
              if (G != 256) { pool_filter(wave0, bx, G); if (l == 0) { pro_convert(lds, wave0, bx, G); moe_convert_wg(lds, wave0, bx, G, MOE_TILES, MOE_TILES + 88); } moe_convert_wg(lds, wave0, bx, G, l == 0 ? 0 : MF_C, l == 0 ? MF_A : MF_D); } } }
        GRID_BAR();
        { unsigned char* ws = kws(); OPQ_GB; pg8::Sched2D S; S.init(ws + WS_H, (bf16*)(ws + WS_WGLU) + (size_t)l * 512 * 512, DSSM * 2, DSSM * 2, M, DSSM, G, bx);
          EpiGlu E{(const bf16*)(ws + WS_H), kin(12) + l * DSSM, (bf16*)(ws + WS_MIXED)}; pg8::gemm_phase(lds, pg8::GemmP{DSSM * 2, DSSM * 2, DSSM / 64}, S, E, wave0);
          { const bool part = G > 128; if (!part || bx >= 128) { const int fr = part ? bx - 128 : bx, nf = part ? G - 128 : G;
              if (l == 0) misc_fill(P, lds, wave0, fr, nf);
              moe_convert_wg(lds, wave0, fr, nf, l == 0 ? MF_A : MF_D, l == 0 ? MF_B : (G == 256 ? MT_END - MT_POS - MT_RT : MT_END)); }
            else if (l == 0 && G == 256) { if (wave0 == 0) pool_fold_item_rolled(P, 896 + bx, (LAS float*)lds, hw_lane()); } } }
        GRID_BAR();
        { unsigned char* ws = kws(); OPQ_GB; pg8::Sched2D S; S.init(ws + WS_MIXED, (bf16*)(ws + WS_WOUT) + (size_t)l * D * D, D * 2, D * 2, M, D, G, bx);
          EpiRes E{nullptr, (bf16*)(ws + WS_XB), (float*)(ws + WS_STATS), nullptr};     pg8::gemm_phase(lds, pg8::GemmP{D * 2, D * 2, D / 64}, S, E, wave0); }
        GRID_BAR();
        if (l == 0) {
            { unsigned char* ws = kws(); OPQ_GB; pg8::Sched2D S; S.init(ws + WS_XB, ws + WS_WGU, D * 2, D * 2, M, 2 * DFF, G, bx);
              EpiUp E{(const float*)(ws + WS_STATS), ws + WS_HID}; pg8::gemm_phase(lds, pg8::GemmP{D * 2, D * 2, D / 64}, S, E, wave0);
              { constexpr int NU = (M / 256) * (2 * DFF / 256); const int rem = NU % G;
                if (rem != 0) { if (bx >= rem) moe_convert_wg(lds, wave0, bx - rem, G - rem, MF_B, MF_C); } else moe_convert_wg(lds, wave0, bx, G, MF_B, MF_C); } }
            GRID_BAR();
            { unsigned char* ws = kws(); OPQ_GB; pg8::Sched2D S; S.init(ws + WS_HID, ws + WS_WD, DFF, DFF, M, D, G, bx);
              EpiRes E{nullptr, (bf16*)(ws + WS_XB), (float*)(ws + WS_STATS), nullptr}; pg8::gemm_phase<EpiRes, pg8::Sched2D, true>(lds, pg8::GemmP{DFF, DFF, DFF / 128}, S, E, wave0); }
            GRID_BAR();
        }
    }
    { OPQ_GB; if (G == 256) { if (bx < 128) routing_phase(P, lds, wave0, true); else moe_convert_wg(lds, wave0, bx - 128, 128, MT_END - MT_POS - MT_RT, MT_END - MT_POS); } else routing_phase(P, lds, wave0); }
    GRID_BAR();
    { OPQ_GB; if (G == 256) { if (bx < 32) pos_phase(P, wave0, true); else moe_convert_wg(lds, wave0, bx - 32, 224, MT_END - MT_POS, MT_END); } else pos_phase(P, wave0); }
    GRID_BAR();
    { unsigned char* ws = kws(); OPQ_GB; pg8::SchedMoe<true> S; S.init(lds, wave0 * 64 + hw_lane(), ws + WS_XB8, ws + WS_MWGU, (size_t)2 * DFF * D, D, D, 2 * DFF, G, bx);
      EpiUpMoe E{ws + WS_HIDM}; pg8::gemm_phase<EpiUpMoe, pg8::SchedMoe<true>, true>(lds, pg8::GemmP{D, D, D / 128}, S, E, wave0);
      { const int rem = S.nwg % G, nidle = G - rem;
        if (rem != 0 && 2 * nidle >= G) { if (bx >= rem) moe_convert_wg(lds, wave0, bx - rem, nidle, MT_END, MOE_TILES); } else moe_convert_wg(lds, wave0, bx, G, MT_END, MOE_TILES); } }
    GRID_BAR();
    { unsigned char* ws = kws(); OPQ_GB; pg8::SchedMoe<false> S; S.init(lds, wave0 * 64 + hw_lane(), ws + WS_HIDM, ws + WS_MWD, (size_t)D * DFF, DFF, DFF, D, G, bx);
      EpiDownMoe E{(bf16*)(ws + WS_Y)}; pg8::gemm_phase<EpiDownMoe, pg8::SchedMoe<false>, true>(lds, pg8::GemmP{DFF, DFF, DFF / 128}, S, E, wave0); }
    GRID_BAR();
    final_phase(P, wave0);
}

extern "C" void kernel_launch(void* const* d_in, const int* in_sizes, int n_in, void* d_out, int out_size, void* d_ws, size_t ws_size, hipStream_t stream) {
    static int grid = 0;
    if (grid == 0) {
        if (n_in != 25 || in_sizes[0] != M * D || out_size != M * D || ws_size < WS_END) { fprintf(stderr, "kernel_launch: unexpected shapes / workspace (n_in %d, ws %zu)\n", n_in, ws_size); grid = -1; return; }
        int dev = 0, cus = 0, per_cu = 0;
        if (hipGetDevice(&dev) != hipSuccess || hipDeviceGetAttribute(&cus, hipDeviceAttributeMultiprocessorCount, dev) != hipSuccess) { grid = -1; return; }
        if (hipFuncSetAttribute((const void*)trunk_fwd, hipFuncAttributeMaxDynamicSharedMemorySize, LDS_BYTES) != hipSuccess) { grid = -1; return; }
        if (hipOccupancyMaxActiveBlocksPerMultiprocessor(&per_cu, (const void*)trunk_fwd, NWAVES * 64, LDS_BYTES) != hipSuccess || per_cu < 1) { fprintf(stderr, "kernel_launch: occupancy query says %d\n", per_cu); }
        (void)hipGetLastError();
        grid = cus;
    }
    if (grid < 0) return;
    (void)hipMemsetAsync((char*)d_ws + WS_CTL, 0, CTL_ZERO_BYTES, stream);
    Ptrs p{};
    for (int i = 0; i < 25; ++i) p.in[i] = (const float*)d_in[i];
    p.out = (float*)d_out; p.ws = (unsigned char*)d_ws;
    hipLaunchKernelGGL(trunk_fwd, dim3(grid), dim3(NWAVES * 64), LDS_BYTES, stream, p);
}
```

```cpp
#include <hip/hip_runtime.h>
#include <cstdio>
#include <cstdint>

#define LAS __attribute__((address_space(3)))
#define GAS __attribute__((address_space(1)))
typedef unsigned short bf16;
typedef short bf16x8 __attribute__((ext_vector_type(8)));
typedef float f32x4 __attribute__((ext_vector_type(4)));
typedef float f32x2 __attribute__((ext_vector_type(2)));
typedef unsigned u32x4 __attribute__((ext_vector_type(4)));
typedef unsigned u32x2 __attribute__((ext_vector_type(2)));

constexpr int BATCH = 8, SEQ = 2048, D = 1024, M = BATCH * SEQ;
constexpr int DSSM = 512, NH = 32, SG = 16, SP = 64, TC = 16  , NR = M / TC  , UZK = TC * SG + 2 * SP  ;
constexpr int DPOOL = 512, DFF = 2816, NE = 8;
constexpr float RMS_EPS = 1e-6f;
constexpr int NWAVES = 8;

constexpr size_t MiB = 1u << 20;
constexpr size_t WS_CTL = 0, CTL_ZERO_BYTES = 16384;
constexpr size_t WS_STATS = 1 * MiB;
constexpr size_t WS_TOK = 2 * MiB;
constexpr size_t WS_CNT = WS_TOK + 256 * 1024;
constexpr size_t WS_POS = WS_CNT + 16 * 1024;
constexpr size_t WS_ROWTOK = WS_POS + 128 * 1024;
constexpr size_t WS_ROWINV = WS_ROWTOK + 192 * 1024;
constexpr size_t WS_TILES = WS_ROWINV + 192 * 1024;
constexpr size_t WS_LAMT = 3 * MiB;
constexpr size_t WS_MWGU = 4 * MiB;
constexpr size_t WS_MWD = 92 * MiB;
constexpr size_t WS_XB = 136 * MiB;
constexpr size_t WS_MIXED = 168 * MiB;
constexpr size_t WS_WIN = 200 * MiB;
constexpr size_t WS_WGLU = 204 * MiB;
constexpr size_t WS_WOUT = 205 * MiB;
constexpr size_t WS_TW = 209 * MiB;
constexpr size_t WS_WE = 221 * MiB;
constexpr size_t WS_WGU = 229 * MiB;
constexpr size_t WS_WD = 240 * MiB;
constexpr size_t WS_UZ = 246 * MiB;
constexpr size_t WS_E = 270 * MiB;
constexpr size_t WS_V = 286 * MiB;
constexpr size_t WS_H = 302 * MiB;
constexpr size_t WS_HID = 246 * MiB;
constexpr size_t WS_HIDM = 168 * MiB;
constexpr size_t WS_XB8 = 72 * MiB;
constexpr size_t WS_Y = WS_MWGU;
constexpr int NASG = 2 * M;
constexpr size_t WS_END = 346 * MiB;
static_assert(WS_HIDM + (size_t)(NASG + 256) * DFF * 2 <= WS_END && (size_t)(NASG + 4 * 8 * 256) * D * 2 <= WS_MWD - WS_MWGU && WS_TILES + 4096 <= 3 * MiB, "d_ws map");
constexpr int CW_BAR = 0;

constexpr int RING_BYTES = 131072, LDSCTL_OFF = RING_BYTES, MISC_OFF = LDSCTL_OFF + 320, LDS_BYTES = 147456;

#define LDS_WAIT() asm volatile("s_waitcnt lgkmcnt(0)" ::: "memory")
#define VM_WAIT() asm volatile("s_waitcnt vmcnt(0)" ::: "memory")

__device__ __forceinline__ unsigned f2bf(float f) { unsigned u = __builtin_bit_cast(unsigned, f); return (u + 0x7fffu + ((u >> 16) & 1u)) >> 16; }
typedef __bf16 bf16x2_t __attribute__((ext_vector_type(2)));
__device__ __forceinline__ unsigned pk2(float lo, float hi) { const f32x2 v = {lo, hi}; return __builtin_bit_cast(unsigned, __builtin_convertvector(v, bf16x2_t)); }
__device__ __forceinline__ float u2f(unsigned u) { return __builtin_bit_cast(float, u); }
__device__ __forceinline__ unsigned f2u(float f) { return __builtin_bit_cast(unsigned, f); }
__device__ __forceinline__ unsigned pk4_fp8(float a, float b, float c, float d) {
    a = __builtin_amdgcn_fmed3f(a, -448.f, 448.f); b = __builtin_amdgcn_fmed3f(b, -448.f, 448.f); c = __builtin_amdgcn_fmed3f(c, -448.f, 448.f); d = __builtin_amdgcn_fmed3f(d, -448.f, 448.f);
    int p = __builtin_amdgcn_cvt_pk_fp8_f32(a, b, 0, false); p = __builtin_amdgcn_cvt_pk_fp8_f32(c, d, p, true); return (unsigned)p; }
__device__ __forceinline__ float bf_lo(unsigned w) { return __builtin_bit_cast(float, w << 16); }
__device__ __forceinline__ float bf_hi(unsigned w) { return __builtin_bit_cast(float, w & 0xffff0000u); }
__device__ __forceinline__ float fast_sigmoid(float v) { return __builtin_amdgcn_rcpf(1.0f + __expf(-v)); }
__device__ __forceinline__ float gelu_tanh(float x) { const float w = __builtin_fmaf(x * x, -0.10294324f, -2.3022082f);
    return x * __builtin_amdgcn_rcpf(1.0f + __builtin_amdgcn_exp2f(x * w)); }
__device__ __forceinline__ float shx(float v, int lane, int mask) { return __builtin_bit_cast(float, __builtin_amdgcn_ds_bpermute((lane ^ mask) << 2, __builtin_bit_cast(int, v))); }
__device__ __forceinline__ float wave_sum(float v, int lane) {
#pragma unroll
    for (int o = 1; o < 64; o <<= 1) v += shx(v, lane, o);
    return v;
}

namespace pg8 {
constexpr int BM = 256, BK = 64, HALF = 128, HTB = HALF * BK * 2, STAGE_BYTES = 8 * HTB, NXCD = 8, WGM = 8;
__host__ __device__ __forceinline__ int lds_byte(int r, int c) { const int st = (r >> 4) * 2 + (c >> 5), rr = r & 15, cc = c & 31, ob = rr * 64 + cc * 2; return st * 1024 + (ob ^ (((ob >> 9) & 1) << 5)); }
__host__ __device__ __forceinline__ void stage_rc(int b, int& R, int& C) { const int st = b / 1024, sb = b % 1024, swz = sb ^ (((sb >> 9) & 1) << 5); R = (st >> 1) * 16 + swz / 64; C = (st & 1) * 32 + (swz % 64) / 2; }
__host__ __device__ __forceinline__ int perm32(int rho) { const int n = rho >> 4, i = rho & 15; return 8 * (i >> 2) + 4 * n + (i & 3); }

struct Unit { const char* a; const char* b; const int* rows; int pm, pn, x, valid, nt; };
struct GemmP { int ldaB, ldbB, nt; };

struct Sched2D {
    static constexpr bool GATHER = false, VARNT = false;
    const char* A; const char* B; int ldaB, ldbB, nM, nN, nwg, G, c;
    __device__ __forceinline__ void init(const void* A_, const void* B_, int ldaB_, int ldbB_, int Mr, int Nc, int G_, int c_) { A = (const char*)A_; B = (const char*)B_; ldaB = ldaB_; ldbB = ldbB_; nM = Mr / BM; nN = Nc / BM; nwg = nM * nN; G = G_; c = c_; }
    __device__ __forceinline__ bool next(int i, Unit& u) const {
        const long L = (long)i * G + c; if (L >= nwg) return false;
        int wgid = (int)L; { const int q = nwg / NXCD, r = nwg % NXCD, xcd = wgid % NXCD, off = wgid / NXCD; wgid = (xcd < r ? xcd * (q + 1) : r * (q + 1) + (xcd - r) * q) + off; }
        const int nig = WGM * nN, gid = wgid / nig, fm = gid * WGM, gsz = (nM - fm) < WGM ? (nM - fm) : WGM;
        u.pm = fm + ((wgid % nig) % gsz); u.pn = (wgid % nig) / gsz; u.x = 0; u.valid = BM; u.rows = nullptr;
        u.a = A + (size_t)u.pm * BM * ldaB; u.b = B + (size_t)u.pn * BM * ldbB; return true;
    }
};
struct SchedHead {
    static constexpr bool GATHER = false, VARNT = false;
    const char* A; const char* B; size_t aStride, bStride; int ldaB, un;
    __device__ __forceinline__ bool next(int i, Unit& u) const {
        if (i > 0 || un < 0) return false;
        const int head = un >> 2, pm = un & 3;
        u.pm = pm; u.pn = 0; u.x = head; u.valid = BM; u.rows = nullptr; u.a = A + (size_t)head * aStride + (size_t)pm * BM * ldaB; u.b = B + (size_t)head * bStride; return true;
    }
};
__device__ __forceinline__ int head_unit_of(int i, int G, int c) { if (G == 256) { const int x = c & 7, idx = c >> 3; return (i == 0 && idx < 16) ? x * 16 + idx : -1; } const int un = i * G + c; return un < 128 ? un : -1; }

__device__ __forceinline__ unsigned char* kws_();
constexpr size_t WS_TILES_ = WS_TILES, WS_ROWTOK_ = WS_ROWTOK; constexpr int NASG_ = 2 * M;
constexpr int TILE_LDS_OFF = 131072 + 1024;
constexpr int SC_LDS_OFF = TILE_LDS_OFF + 4096 + 8192;
constexpr int IX_LDS_OFF = TILE_LDS_OFF + 4096;
template <bool GA> struct SchedMoe {
    static constexpr bool GATHER = GA, VARNT = !GA;
    static constexpr int KSPLIT = 4, KSL = 6;
    const char* A; const char* B; size_t bStrideE; LAS const int* tl; int ldaB, ldbB, nM, nN, nwg, G, c, nsub, ntFull;
    __device__ __forceinline__ void init(LAS unsigned char* lds, int tid, const void* A_, const void* B_, size_t bStrideE_, int ldaB_, int ldbB_, int Nc, int G_, int c_) {
        A = (const char*)A_; B = (const char*)B_; bStrideE = bStrideE_; ldaB = ldaB_; ldbB = ldbB_;
        LAS int* t = (LAS int*)(lds + TILE_LDS_OFF); const int* g = (const int*)(kws_() + WS_TILES_);
        for (int i = tid; i < 1024; i += 512) t[i] = g[i];
        asm volatile("s_waitcnt vmcnt(0) lgkmcnt(0)" ::: "memory"); __syncthreads();
        tl = t; nM = __builtin_amdgcn_readfirstlane(t[255 * 4]); nN = Nc / BM; G = G_; c = c_; nsub = 0; ntFull = ldaB_ / 128;
        if constexpr (!GA) { constexpr int nMain = 128;        if (nM > nMain) { nsub = __builtin_amdgcn_readfirstlane((nM - nMain) * nN * KSPLIT); nM = nMain; } }
        nwg = __builtin_amdgcn_readfirstlane(nM * nN); }
    __device__ __forceinline__ bool next(int i, Unit& u) const {
        const int L = i * G + c; size_t ko = 0; u.nt = ntFull;
        if (L >= nwg) { if (GA || L - nwg >= nsub) return false;
            const int j = L - nwg, sl = j & (KSPLIT - 1), o = j / (KSPLIT * nN); u.pn = (j / KSPLIT) % nN; u.pm = nM + o;
            u.x = NASG_ + (sl * 8 + o) * BM; ko = (size_t)(sl * KSL * 128); u.nt = sl < KSPLIT - 1 ? KSL : ntFull - (KSPLIT - 1) * KSL;
        } else {
            int wgid = L; { const int q = nwg / NXCD, r = nwg % NXCD, xcd = wgid % NXCD, off = wgid / NXCD; wgid = (xcd < r ? xcd * (q + 1) : r * (q + 1) + (xcd - r) * q) + off; }
            const int nig = WGM * nN, gid = wgid / nig, fm = gid * WGM, gsz = (nM - fm) < WGM ? (nM - fm) : WGM;
            u.pm = fm + ((wgid % nig) % gsz); u.pn = (wgid % nig) / gsz; u.x = -1; }
        const int e = __builtin_amdgcn_readfirstlane(tl[u.pm * 4]), row0 = __builtin_amdgcn_readfirstlane(tl[u.pm * 4 + 1]); u.valid = __builtin_amdgcn_readfirstlane(tl[u.pm * 4 + 2]); if (u.x < 0) u.x = row0;
        u.rows = (const int*)(kws_() + WS_ROWTOK_) + row0; u.a = GA ? A : A + (size_t)row0 * ldaB + ko; u.b = B + (size_t)e * bStrideE + (size_t)u.pn * BM * ldbB + ko; return true;
    }
};

typedef int i32x4 __attribute__((ext_vector_type(4)));
typedef int i32x8 __attribute__((ext_vector_type(8)));
template <int SX, int SY> __device__ __forceinline__ f32x4 mfma8_t(bf16x8 x0, bf16x8 x1, bf16x8 y0, bf16x8 y1, f32x4 c) {
    const i32x8 x = __builtin_shufflevector(__builtin_bit_cast(i32x4, x0), __builtin_bit_cast(i32x4, x1), 0, 1, 2, 3, 4, 5, 6, 7), y = __builtin_shufflevector(__builtin_bit_cast(i32x4, y0), __builtin_bit_cast(i32x4, y1), 0, 1, 2, 3, 4, 5, 6, 7);
    return __builtin_amdgcn_mfma_scale_f32_16x16x128_f8f6f4(x, y, c, 0, 0, 0, SX, 0, SY);
}
#define mfma8(x0, x1, y0, y1, c, sx, sy) mfma8_t<sx, sy>(x0, x1, y0, y1, c)
template <class Epi, class Sched, bool F8 = false>
__device__ __forceinline__ void gemm_phase(LAS unsigned char* lds, const GemmP g, const Sched& S, const Epi& E, int wid) {
    int lane; asm volatile("v_mbcnt_lo_u32_b32 %0, -1, 0\n\tv_mbcnt_hi_u32_b32 %0, -1, %0" : "=v"(lane));
    asm volatile("" : "+s"(wid));
    const int tid = wid * 64 + lane, wr = wid >> 2, wc = wid & 3, fr = lane & 15, fq = lane >> 4;
    constexpr bool GA = Sched::GATHER;
    unsigned vAc[2][2], vAn[2][2], voffB[2];
#pragma unroll
    for (int i = 0; i < 2; ++i) { int R, C; stage_rc(tid * 16 + i * 8192, R, C); const int Rb = Epi::PERM ? ((R & ~31) + perm32(R & 31)) : R;
        voffB[i] = (unsigned)(Rb * g.ldbB + C * 2); }
    const size_t kstep = (size_t)(BK * 2);
    const size_t hB = (size_t)HALF * g.ldbB;
    const unsigned ldsw = (unsigned)wid * 1024u;
    const int aoff = lds_byte(wr * 64 + fr, fq * 8), boff = lds_byte(wc * 32 + fr, fq * 8);
    constexpr int KOFF = 1024;
#define PG8_SA(b, h) (((b) * 2 + (h)) * HTB)
#define PG8_SB(b, h) ((4 + (b) * 2 + (h)) * HTB)
#define PG8_STAGE(bufoff, gbase, voff) do { _Pragma("unroll") for (int _i = 0; _i < 2; ++_i) { unsigned vo_ = (voff)[_i]; asm volatile("" : "+v"(vo_));     \
        __builtin_amdgcn_global_load_lds((const unsigned*)((const char*)(gbase) + vo_), (LAS unsigned*)(lds + (bufoff) + ldsw + _i * 8192), 16, 0, 0); } } while (0)
#define PG8_LDA(dst, b, h) do { _Pragma("unroll") for (int m = 0; m < 4; ++m) _Pragma("unroll") for (int k = 0; k < 2; ++k) dst[m][k] = *(const LAS bf16x8*)(lds + PG8_SA(b, h) + aoff + m * 2048 + k * KOFF); } while (0)
#define PG8_LDB(dst, b, h) do { _Pragma("unroll") for (int n = 0; n < 2; ++n) _Pragma("unroll") for (int k = 0; k < 2; ++k) dst[n][k] = *(const LAS bf16x8*)(lds + PG8_SB(b, h) + boff + n * 2048 + k * KOFF); } while (0)
#define PG8_MMA(ai, bj, At, Bt) do { __builtin_amdgcn_s_setprio(1); _Pragma("unroll") for (int m = 0; m < 4; ++m) _Pragma("unroll") for (int n = 0; n < 2; ++n) { \
        if constexpr (F8) acc[ai][bj][m][n] = mfma8(Bt[n][0], Bt[n][1], At[m][0], At[m][1], acc[ai][bj][m][n], Epi::SCALE_B, Epi::SCALE_A); \
        else { _Pragma("unroll") for (int k = 0; k < 2; ++k) acc[ai][bj][m][n] = __builtin_amdgcn_mfma_f32_16x16x32_bf16(Bt[n][k], At[m][k], acc[ai][bj][m][n], 0, 0, 0); } } __builtin_amdgcn_s_setprio(0); } while (0)
#define PG8_MMA0(ai, bj, At, Bt) do { __builtin_amdgcn_s_setprio(1); _Pragma("unroll") for (int m = 0; m < 4; ++m) _Pragma("unroll") for (int n = 0; n < 2; ++n) { \
        if constexpr (F8) acc[ai][bj][m][n] = mfma8(Bt[n][0], Bt[n][1], At[m][0], At[m][1], zero4_, Epi::SCALE_B, Epi::SCALE_A); \
        else { acc[ai][bj][m][n] = __builtin_amdgcn_mfma_f32_16x16x32_bf16(Bt[n][0], At[m][0], zero4_, 0, 0, 0); acc[ai][bj][m][n] = __builtin_amdgcn_mfma_f32_16x16x32_bf16(Bt[n][1], At[m][1], acc[ai][bj][m][n], 0, 0, 0); } } __builtin_amdgcn_s_setprio(0); } while (0)
#define PG8_WAIT_V(n) asm volatile("s_waitcnt vmcnt(" #n ")" ::: "memory")
#define PG8_WAIT_L(n) asm volatile("s_waitcnt lgkmcnt(" #n ")" ::: "memory")
#define PG8_BAR __builtin_amdgcn_s_barrier()
#define PG8_SCHED __builtin_amdgcn_sched_barrier(0)
    Unit cur, nxt; int ui = 0;
    if (!S.next(0, cur)) return;
    f32x4 acc[2][2][4][2]; const f32x4 zero4_ = {0.f, 0.f, 0.f, 0.f};
    if constexpr (!Epi::PEEL) {
#pragma unroll
    for (int a = 0; a < 2; ++a)
#pragma unroll
        for (int b = 0; b < 2; ++b)
#pragma unroll
            for (int m = 0; m < 4; ++m)
#pragma unroll
                for (int n = 0; n < 2; ++n) acc[a][b][m][n] = zero4_; }
    bf16x8 At[4][2], B0[2][2], B1[2][2];
    const char* cA = cur.a; const char* cB = cur.b;
    const size_t hA = GA ? (size_t)0 : (size_t)HALF * g.ldaB;
#pragma unroll
    for (int i = 0; i < 2; ++i) { int R, C; stage_rc(tid * 16 + i * 8192, R, C);
#pragma unroll
        for (int h = 0; h < 2; ++h) { const int rr = GA ? cur.rows[h * HALF + R] : R; vAc[h][i] = (unsigned)(rr * g.ldaB + C * 2); vAn[h][i] = vAc[h][i]; } }
#define PG8_STAGE_A(bufoff, gbase, h) PG8_STAGE(bufoff, (gbase) + (h) * hA, vAc[GA ? (h) : 0])
    if constexpr (GA) { Unit t1; if (S.next(1, t1)) { LAS unsigned* ix = (LAS unsigned*)(lds + IX_LDS_OFF) + tid * 4;
#pragma unroll
            for (int i = 0; i < 2; ++i) { int R, C; stage_rc(tid * 16 + i * 8192, R, C);
#pragma unroll
                for (int h = 0; h < 2; ++h) ix[h * 2 + i] = (unsigned)(t1.rows[h * HALF + R] * g.ldaB + C * 2); } } }
    float sc0_ = 0.f; if constexpr (Epi::SC) { if (wid < 4) sc0_ = E.scale_of(cur, tid); }
    PG8_STAGE(PG8_SB(0, 0), cB, voffB); PG8_STAGE(PG8_SB(0, 1), cB + hB, voffB); PG8_STAGE_A(PG8_SA(0, 0), cA, 0); PG8_STAGE_A(PG8_SA(0, 1), cA, 1);
    if (wr == 1) PG8_BAR;
    PG8_WAIT_V(2); PG8_BAR;
    PG8_STAGE(PG8_SB(1, 0), cB + kstep, voffB); PG8_STAGE_A(PG8_SA(1, 0), cA + kstep, 0); PG8_STAGE(PG8_SB(1, 1), cB + hB + kstep, voffB);
    PG8_WAIT_V(6); PG8_BAR;
    if constexpr (Epi::SC) { if (wid < 4) ((LAS float*)(lds + SC_LDS_OFF))[tid] = sc0_; }
    for (;;) {
        const bool has_next = S.next(ui + 1, nxt);
        const char* nA = has_next ? nxt.a : cA; const char* nB = has_next ? nxt.b : cB;
        if constexpr (GA) { if (has_next) {
                int l3_; asm volatile("v_mbcnt_lo_u32_b32 %0, -1, 0\n\tv_mbcnt_hi_u32_b32 %0, -1, %0" : "=v"(l3_));
                const u32x4 o4 = *((const LAS u32x4*)(lds + IX_LDS_OFF) + (wid * 64 + l3_));
                vAn[0][0] = o4.x; vAn[0][1] = o4.y; vAn[1][0] = o4.z; vAn[1][1] = o4.w; } }
        int nt = Sched::VARNT ? cur.nt : g.nt; asm volatile("" : "+s"(nt));
#define PG8_TRIPBODY(MA) { const bool last = (t == nt - 2); \
            const char* a1 = cA + (size_t)(t + 1) * kstep; \
            const char* a2 = last ? nA : cA + (size_t)(t + 2) * kstep; const char* b2 = last ? nB : cB + (size_t)(t + 2) * kstep; \
            const char* a3 = a2 + kstep; const char* b3 = b2 + kstep; \
            PG8_LDB(B0, 0, 0); PG8_LDB(B1, 0, 1); PG8_SCHED; PG8_LDA(At, 0, 0); PG8_STAGE_A(PG8_SA(1, 1), a1, 1); \
            if constexpr (GA) { if (last) {               \
                _Pragma("unroll") for (int h = 0; h < 2; ++h) _Pragma("unroll") for (int i = 0; i < 2; ++i) vAc[h][i] = vAn[h][i]; } } \
            PG8_WAIT_V(8); PG8_WAIT_L(0); PG8_BAR; MA(0, 0, At, B0); MA(0, 1, At, B1); PG8_BAR; PG8_SCHED; \
            PG8_LDA(At, 0, 1); PG8_STAGE(PG8_SB(0, 0), b2, voffB); PG8_STAGE(PG8_SB(0, 1), b2 + hB, voffB); PG8_STAGE_A(PG8_SA(0, 0), a2, 0); \
            PG8_WAIT_V(8); PG8_WAIT_L(0); PG8_BAR; MA(1, 0, At, B0); MA(1, 1, At, B1); PG8_BAR; PG8_SCHED; \
            PG8_LDB(B0, 1, 0); PG8_LDB(B1, 1, 1); PG8_SCHED; PG8_LDA(At, 1, 0); PG8_STAGE_A(PG8_SA(0, 1), a2, 1); \
            PG8_WAIT_V(8); PG8_WAIT_L(0); PG8_BAR; PG8_MMA(0, 0, At, B0); PG8_MMA(0, 1, At, B1); PG8_BAR; PG8_SCHED; \
            PG8_LDA(At, 1, 1); PG8_STAGE(PG8_SB(1, 0), b3, voffB); PG8_STAGE(PG8_SB(1, 1), b3 + hB, voffB); PG8_STAGE_A(PG8_SA(1, 0), a3, 0); \
            PG8_WAIT_V(8); PG8_WAIT_L(0); PG8_BAR; PG8_MMA(1, 0, At, B0); PG8_MMA(1, 1, At, B1); PG8_BAR; PG8_SCHED; }
        if constexpr (Epi::PEEL) { { const int t = 0; PG8_TRIPBODY(PG8_MMA0) } for (int t = 2; t < nt; t += 2) PG8_TRIPBODY(PG8_MMA) }
        else { for (int t = 0; t < nt; t += 2) PG8_TRIPBODY(PG8_MMA) }
#undef PG8_TRIPBODY
        if (wr == 0) PG8_BAR;
        { int ln_; asm volatile("v_mbcnt_lo_u32_b32 %0, -1, 0\n\tv_mbcnt_hi_u32_b32 %0, -1, %0" : "=v"(ln_));
          if constexpr (GA) { Unit t2; int r2[4] = {0, 0, 0, 0}; const bool has2 = has_next && S.next(ui + 2, t2);
              if (has2) { const int tid2 = wid * 64 + ln_;
#pragma unroll
                  for (int i = 0; i < 2; ++i) { int R, C; stage_rc(tid2 * 16 + i * 8192, R, C);
#pragma unroll
                      for (int h = 0; h < 2; ++h) r2[h * 2 + i] = t2.rows[h * HALF + R]; } }
              float scn_ = 0.f; if constexpr (Epi::SC) { if (has_next && wid < 4) scn_ = E.scale_of(nxt, wid * 64 + ln_); }
              E(acc, cur, wr, wc, ln_ & 15, ln_ >> 4, (LAS const float*)(lds + SC_LDS_OFF) + (ui & 1) * 256);
              if constexpr (Epi::SC) { if (has_next && wid < 4) { int l4_; asm volatile("v_mbcnt_lo_u32_b32 %0, -1, 0\n\tv_mbcnt_hi_u32_b32 %0, -1, %0" : "=v"(l4_)); ((LAS float*)(lds + SC_LDS_OFF))[((ui + 1) & 1) * 256 + wid * 64 + l4_] = scn_; } }
              if (has2) { int l2_; asm volatile("v_mbcnt_lo_u32_b32 %0, -1, 0\n\tv_mbcnt_hi_u32_b32 %0, -1, %0" : "=v"(l2_)); const int tid2 = wid * 64 + l2_; u32x4 o4;
                  { int R, C; stage_rc(tid2 * 16, R, C); o4.x = (unsigned)(r2[0] * g.ldaB + C * 2); o4.z = (unsigned)(r2[2] * g.ldaB + C * 2); }
                  { int R, C; stage_rc(tid2 * 16 + 8192, R, C); o4.y = (unsigned)(r2[1] * g.ldaB + C * 2); o4.w = (unsigned)(r2[3] * g.ldaB + C * 2); }
                  *((LAS u32x4*)(lds + IX_LDS_OFF) + tid2) = o4; } }
          else { float scn_ = 0.f; if constexpr (Epi::SC) { if (has_next && wid < 4) scn_ = E.scale_of(nxt, wid * 64 + ln_); }
              E(acc, cur, wr, wc, ln_ & 15, ln_ >> 4, (LAS const float*)(lds + SC_LDS_OFF) + (ui & 1) * 256);
              if constexpr (Epi::SC) { if (has_next && wid < 4) { int l4_; asm volatile("v_mbcnt_lo_u32_b32 %0, -1, 0\n\tv_mbcnt_hi_u32_b32 %0, -1, %0" : "=v"(l4_)); ((LAS float*)(lds + SC_LDS_OFF))[((ui + 1) & 1) * 256 + wid * 64 + l4_] = scn_; } } } }
        if (!has_next) break;
        if constexpr (!Epi::PEEL) {
#pragma unroll
        for (int a = 0; a < 2; ++a)
#pragma unroll
            for (int b = 0; b < 2; ++b)
#pragma unroll
                for (int m = 0; m < 4; ++m)
#pragma unroll
                    for (int n = 0; n < 2; ++n) acc[a][b][m][n] = zero4_; }
        cur = nxt; cA = nA; cB = nB; ++ui;
        if (wr == 1) PG8_BAR;
    }
    PG8_WAIT_V(0);
    PG8_BAR;
#undef PG8_SA
#undef PG8_SB
#undef PG8_STAGE
#undef PG8_STAGE_A
#undef PG8_LDA
#undef PG8_LDB
#undef PG8_MMA
#undef PG8_MMA0
#undef PG8_WAIT_V
#undef PG8_WAIT_L
#undef PG8_BAR
#undef PG8_SCHED
}
}

using pg8::Unit;
typedef f32x4 Acc[2][2][4][2];

__device__ __forceinline__ float stats_inv(const float* stats, int row) {
    const f32x4* p = (const f32x4*)(stats + (size_t)row * 16); const f32x4 a = p[0], b = p[1], c = p[2], d = p[3];
    const float s = (((a[0] + a[1]) + (a[2] + a[3])) + ((b[0] + b[1]) + (b[2] + b[3]))) + (((c[0] + c[1]) + (c[2] + c[3])) + ((d[0] + d[1]) + (d[2] + d[3])));
    return __builtin_amdgcn_rsqf(s * (1.0f / D) + RMS_EPS);
}
#define LOAD_SC8(inv) do { _Pragma("unroll") for (int ai_ = 0; ai_ < 2; ++ai_) _Pragma("unroll") for (int m_ = 0; m_ < 4; ++m_) inv[ai_][m_] = sc[ai_ * 128 + wr * 64 + m_ * 16 + fr]; } while (0)
__device__ __forceinline__ u32x4 pack8(const f32x4 a, const f32x4 b) { u32x4 w; w.x = pk2(a[0], a[1]); w.y = pk2(a[2], a[3]); w.z = pk2(b[0], b[1]); w.w = pk2(b[2], b[3]); return w; }

struct EpiInProj {
    static constexpr bool PERM = true, SC = true, PEEL = false;
    const float* stats; bf16* UZ; bf16* V;
    __device__ __forceinline__ float scale_of(const Unit& u, int r) const { return stats_inv(stats, u.pm * 256 + r); }
    __device__ __forceinline__ void operator()(const Acc& acc, const Unit& u, int wr, int wc, int fr, int fq, LAS const float* sc) const {
        const int row0 = u.pm * 256 + wr * 64 + fr; float inv[2][4]; LOAD_SC8(inv);
#pragma unroll
        for (int ai = 0; ai < 2; ++ai)
#pragma unroll
            for (int m = 0; m < 4; ++m) { const int row = row0 + ai * 128 + m * 16; const float s = inv[ai][m];
#pragma unroll
                for (int bj = 0; bj < 2; ++bj) { const int c8 = u.pn * 256 + bj * 128 + wc * 32 + 8 * fq; const u32x4 w = pack8(acc[ai][bj][m][0] * s, acc[ai][bj][m][1] * s);
                    if (u.pn < 2) { const int head = c8 >> 4, g0 = c8 & 15; *(u32x4*)(UZ + ((size_t)(head * NR + (row >> 4)) * UZK + (row & 15) * 16 + g0)) = w; }
                    else *(u32x4*)(V + (size_t)row * DPOOL + (c8 - 512)) = w; } }
    }
};
struct EpiE {
    static constexpr bool PERM = false, SC = false, PEEL = false;
    float* E;
    __device__ __forceinline__ void operator()(const Acc& acc, const Unit& u, int wr, int wc, int fr, int fq, LAS const float* sc) const {
#pragma unroll
        for (int ai = 0; ai < 2; ++ai)
#pragma unroll
            for (int m = 0; m < 4; ++m) { const int row = u.pm * 256 + ai * 128 + wr * 64 + m * 16 + fr; float* rp = E + ((size_t)(u.x * NR + row)) * 128 + wc * 32 + 4 * fq;
#pragma unroll
                for (int n = 0; n < 2; ++n) *(f32x4*)(rp + 16 * n) = acc[ai][0][m][n]; }
    }
};
struct EpiY {
    static constexpr bool PERM = true, SC = false, PEEL = false;
    bf16* H;
    __device__ __forceinline__ void operator()(const Acc& acc, const Unit& u, int wr, int wc, int fr, int fq, LAS const float* sc) const {
#pragma unroll
        for (int ai = 0; ai < 2; ++ai)
#pragma unroll
            for (int m = 0; m < 4; ++m) { const int R = u.pm * 256 + ai * 128 + wr * 64 + m * 16 + fr;
#pragma unroll
                for (int bj = 0; bj < 2; ++bj) { const int c8 = bj * 128 + wc * 32 + 8 * fq, j = c8 >> 4, g0 = c8 & 15; f32x4 a = acc[ai][bj][m][0], b = acc[ai][bj][m][1];
#pragma unroll
                    for (int q = 0; q < 4; ++q) { a[q] = gelu_tanh(a[q]); b[q] = gelu_tanh(b[q]); }
                    *(u32x4*)(H + (size_t)(R * TC + j) * DSSM + u.x * SG + g0) = pack8(a, b); } }
    }
};
struct EpiGlu {
    static constexpr bool PERM = true, SC = false, PEEL = false;
    const bf16* H; const float* bglu; bf16* MIXED;
    __device__ __forceinline__ void operator()(const Acc& acc, const Unit& u, int wr, int wc, int fr, int fq, LAS const float* sc) const {
#pragma unroll
        for (int bj = 0; bj < 2; ++bj) { const int c8 = u.pn * 256 + bj * 128 + wc * 32 + 8 * fq; const f32x4 b0 = *(const f32x4*)(bglu + c8) * -1.4426950408889634f, b1 = *(const f32x4*)(bglu + c8 + 4) * -1.4426950408889634f;
            u32x4 hv[2][4];
#pragma unroll
            for (int ai = 0; ai < 2; ++ai)
#pragma unroll
                for (int m = 0; m < 4; ++m) hv[ai][m] = *(const u32x4*)(H + (size_t)(u.pm * 256 + ai * 128 + wr * 64 + m * 16 + fr) * DSSM + c8);
#pragma unroll
            for (int ai = 0; ai < 2; ++ai)
#pragma unroll
                for (int m = 0; m < 4; ++m) { const int row = u.pm * 256 + ai * 128 + wr * 64 + m * 16 + fr; const u32x4 hw = hv[ai][m];
                    const f32x4 a = acc[ai][bj][m][0] + b0, b = acc[ai][bj][m][1] + b1; f32x4 oa, ob;
                    oa[0] = bf_lo(hw.x) * __builtin_amdgcn_rcpf(1.0f + __builtin_amdgcn_exp2f(a[0])); oa[1] = bf_hi(hw.x) * __builtin_amdgcn_rcpf(1.0f + __builtin_amdgcn_exp2f(a[1])); oa[2] = bf_lo(hw.y) * __builtin_amdgcn_rcpf(1.0f + __builtin_amdgcn_exp2f(a[2])); oa[3] = bf_hi(hw.y) * __builtin_amdgcn_rcpf(1.0f + __builtin_amdgcn_exp2f(a[3]));
                    ob[0] = bf_lo(hw.z) * __builtin_amdgcn_rcpf(1.0f + __builtin_amdgcn_exp2f(b[0])); ob[1] = bf_hi(hw.z) * __builtin_amdgcn_rcpf(1.0f + __builtin_amdgcn_exp2f(b[1])); ob[2] = bf_lo(hw.w) * __builtin_amdgcn_rcpf(1.0f + __builtin_amdgcn_exp2f(b[2])); ob[3] = bf_hi(hw.w) * __builtin_amdgcn_rcpf(1.0f + __builtin_amdgcn_exp2f(b[3]));
                    *(u32x4*)(MIXED + (size_t)row * D + c8) = pack8(oa, ob); } }
    }
};
struct EpiRes {
    static constexpr bool PERM = true, SC = false, PEEL = false; static constexpr int SCALE_A = 0x7d7d7d7d, SCALE_B = 0x79797979;
    const float* srcf; bf16* XB; float* stats; unsigned char* XB8;
    __device__ __forceinline__ void operator()(const Acc& acc, const Unit& u, int wr, int wc, int fr, int fq, LAS const float* sc) const {
        const size_t off0 = (size_t)(u.pm * 256 + wr * 64 + fr) * D + u.pn * 256 + wc * 32 + 8 * fq;
        f32x4 pa[8], pb[8];
#define RES_LOAD(dstv, b) do { _Pragma("unroll") for (int mm = 0; mm < 2; ++mm) _Pragma("unroll") for (int bj = 0; bj < 2; ++bj) { \
            const size_t o_ = off0 + (size_t)(((b) >> 1) * 128 + (((b) & 1) * 2 + mm) * 16) * D + bj * 128; \
            if (srcf) { dstv[(mm * 2 + bj) * 2] = __builtin_nontemporal_load((const f32x4*)(srcf + o_)); dstv[(mm * 2 + bj) * 2 + 1] = __builtin_nontemporal_load((const f32x4*)(srcf + o_ + 4)); } \
            else { const u32x4 w_ = *(const u32x4*)(XB + o_); dstv[(mm * 2 + bj) * 2] = (f32x4){bf_lo(w_.x), bf_hi(w_.x), bf_lo(w_.y), bf_hi(w_.y)}; dstv[(mm * 2 + bj) * 2 + 1] = (f32x4){bf_lo(w_.z), bf_hi(w_.z), bf_lo(w_.w), bf_hi(w_.w)}; } } } while (0)
#define RES_DO(srcv, b) do { _Pragma("unroll") for (int mm = 0; mm < 2; ++mm) { const int ai = (b) >> 1, m = ((b) & 1) * 2 + mm; const int row = u.pm * 256 + ai * 128 + wr * 64 + m * 16 + fr; float ss = 0.f; \
            _Pragma("unroll") for (int bj = 0; bj < 2; ++bj) { const size_t o = off0 + (size_t)(ai * 128 + m * 16) * D + bj * 128; \
                const f32x4 h0 = srcv[(mm * 2 + bj) * 2] + acc[ai][bj][m][0], h1 = srcv[(mm * 2 + bj) * 2 + 1] + acc[ai][bj][m][1]; \
                *(u32x4*)(XB + o) = pack8(h0, h1); \
                if (XB8) { u32x2 w8; w8.x = pk4_fp8(h0[0], h0[1], h0[2], h0[3]); w8.y = pk4_fp8(h1[0], h1[1], h1[2], h1[3]); *(u32x2*)(XB8 + o) = w8; } \
                ss += ((h0[0] * h0[0] + h0[1] * h0[1]) + (h0[2] * h0[2] + h0[3] * h0[3])) + ((h1[0] * h1[0] + h1[1] * h1[1]) + (h1[2] * h1[2] + h1[3] * h1[3])); } \
            { const int lane = fq * 16 + fr; ss += shx(ss, lane, 16); ss += shx(ss, lane, 32); if (fq == 0) stats[(size_t)row * 16 + u.pn * 4 + wc] = ss; } } } while (0)
        RES_LOAD(pa, 0);
        RES_LOAD(pb, 1); RES_DO(pa, 0);
        RES_LOAD(pa, 2); RES_DO(pb, 1);
        RES_LOAD(pb, 3); RES_DO(pa, 2);
        RES_DO(pb, 3);
#undef RES_LOAD
#undef RES_DO
    }
};
struct EpiUp {
    static constexpr bool PERM = false, SC = true, PEEL = true;
    const float* stats; unsigned char* HID;
    __device__ __forceinline__ float scale_of(const Unit& u, int r) const { return stats_inv(stats, u.pm * 256 + r); }
    __device__ __forceinline__ void operator()(const Acc& acc, const Unit& u, int wr, int wc, int fr, int fq, LAS const float* sc) const {
        const int row0 = u.pm * 256 + wr * 64 + fr; float inv[2][4]; LOAD_SC8(inv);
#pragma unroll
        for (int ai = 0; ai < 2; ++ai)
#pragma unroll
            for (int m = 0; m < 4; ++m) { const int row = row0 + ai * 128 + m * 16; const float s = inv[ai][m]; f32x4 o[2];
                const float s2 = s * s;
#pragma unroll
                for (int bj = 0; bj < 2; ++bj) { const f32x4 ag = acc[ai][bj][m][0], au = acc[ai][bj][m][1];
#pragma unroll
                    for (int q = 0; q < 4; ++q) o[bj][q] = ((ag[q] * au[q]) * s2) * __builtin_amdgcn_rcpf(1.0f + __builtin_amdgcn_exp2f(ag[q] * s)); }
                { u32x2 w; w.x = pk4_fp8(o[0][0], o[0][1], o[0][2], o[0][3]); w.y = pk4_fp8(o[1][0], o[1][1], o[1][2], o[1][3]); *(u32x2*)(HID + (size_t)row * DFF + u.pn * 128 + wc * 32 + 8 * fq) = w; } }
    }
};
struct EpiUpMoe {
    static constexpr bool PERM = false, SC = false, PEEL = false; static constexpr int SCALE_A = 0x7c7c7c7c, SCALE_B = 0x79797979;
    unsigned char* HID8;
    __device__ __forceinline__ void operator()(const Acc& acc, const Unit& u, int wr, int wc, int fr, int fq, LAS const float* sc) const {
#pragma unroll
        for (int ai = 0; ai < 2; ++ai)
#pragma unroll
            for (int m = 0; m < 4; ++m) { const int rl = ai * 128 + wr * 64 + m * 16 + fr; const int row = u.x + rl; f32x4 o[2];
#pragma unroll
                for (int bj = 0; bj < 2; ++bj) { const f32x4 ag = acc[ai][bj][m][0], au = acc[ai][bj][m][1];
#pragma unroll
                    for (int q = 0; q < 4; ++q) o[bj][q] = (ag[q] * au[q]) * __builtin_amdgcn_rcpf(1.0f + __builtin_amdgcn_exp2f(ag[q])); }
                if (rl < u.valid) { u32x2 w; w.x = pk4_fp8(o[0][0], o[0][1], o[0][2], o[0][3]); w.y = pk4_fp8(o[1][0], o[1][1], o[1][2], o[1][3]); *(u32x2*)(HID8 + (size_t)row * DFF + u.pn * 128 + wc * 32 + 8 * fq) = w; } }
    }
};
struct EpiDownMoe {
    static constexpr bool PERM = true, SC = false, PEEL = true; static constexpr int SCALE_A = 0x7d7d7d7d, SCALE_B = 0x79797979;
    bf16* Y;
    __device__ __forceinline__ void operator()(const Acc& acc, const Unit& u, int wr, int wc, int fr, int fq, LAS const float* sc) const {
#pragma unroll
        for (int ai = 0; ai < 2; ++ai)
#pragma unroll
            for (int m = 0; m < 4; ++m) { const int rl = ai * 128 + wr * 64 + m * 16 + fr; const int row = u.x + rl;
                if (rl < u.valid) {
#pragma unroll
                    for (int bj = 0; bj < 2; ++bj) *(u32x4*)(Y + (size_t)row * D + u.pn * 256 + bj * 128 + wc * 32 + 8 * fq) = pack8(acc[ai][bj][m][0], acc[ai][bj][m][1]); } }
    }
};

#define XB_TMO      128
#define XB_XCNT(j)  (256  + 64 * (j))
#define XB_XSUB(j)  (1280 + 64 * (j))
#define XB_XGEN(j)  (2304 + 64 * (j))
#define XB_TOP      3328
#define XB_TOPGEN   3392
#define XCD_BAR_WORDS 3456
#define XB_SPIN_CAP (1u << 18)
__device__ __forceinline__ unsigned xb_ld(unsigned* p)              { return __hip_atomic_load(p, __ATOMIC_RELAXED, __HIP_MEMORY_SCOPE_AGENT); }
__device__ __forceinline__ unsigned xb_add(unsigned* p, unsigned v) { return __hip_atomic_fetch_add(p, v, __ATOMIC_RELAXED, __HIP_MEMORY_SCOPE_AGENT); }
__device__ __forceinline__ unsigned xb_xcc_id() { return (unsigned)__builtin_amdgcn_s_getreg((3 << 11) | 20) & 0xFu; }
#define XB_SPIN(cond, bar) do { unsigned _sp = 0; while (cond) { __builtin_amdgcn_s_sleep(1); \
    if ((++_sp & 255u) == 0u) { if (xb_ld(&(bar)[XB_TMO])) break; if (_sp > XB_SPIN_CAP) { atomicAdd(&(bar)[XB_TMO], 1u); break; } } } } while (0)
struct XcdBarrier { unsigned* bar; unsigned x; volatile LAS unsigned* st; };
__device__ __forceinline__ XcdBarrier xcd_barrier_post(unsigned* bar, volatile LAS unsigned* st) {
    XcdBarrier b; b.bar = bar; b.x = xb_xcc_id(); b.st = st;
    if (threadIdx.x == 0) (void)xb_add(&bar[XB_XCNT(b.x)], 1u);
    return b;
}
__device__ __forceinline__ void xcd_barrier_complete(unsigned* bar, unsigned x, unsigned& nloc, unsigned& nx) {
    const unsigned G = gridDim.x * gridDim.y * gridDim.z;
    unsigned sum, cnt, mine, sp = 0u;
    for (;;) {
        sum = 0u; cnt = 0u; mine = 0u;
#pragma unroll
        for (unsigned j = 0; j < 16; ++j) { const unsigned c = xb_ld(&bar[XB_XCNT(j)]); sum += c; cnt += (c > 0u) ? 1u : 0u; mine = (j == x) ? c : mine; }
        if (sum == G) break;
        __builtin_amdgcn_s_sleep(1);
        if ((++sp & 255u) == 0u) { if (xb_ld(&bar[XB_TMO])) break; if (sp > XB_SPIN_CAP) { atomicAdd(&bar[XB_TMO], 1u); break; } }
    }
    nloc = mine > 0u ? mine : 1u; nx = cnt > 0u ? cnt : 1u;
}
__device__ __forceinline__ void xcd_barrier(const XcdBarrier& b, const bool t0  ) {
    asm volatile("s_waitcnt vmcnt(0)" ::: "memory");
    __syncthreads();
    if (t0) {
        unsigned* bar = b.bar;
        __builtin_amdgcn_s_waitcnt(0);
        __builtin_amdgcn_fence(__ATOMIC_ACQUIRE, "agent");
        unsigned nloc = b.st[0], nx = b.st[1];
        if (nloc == 0u) { xcd_barrier_complete(bar, b.x, nloc, nx); b.st[0] = nloc; b.st[1] = nx; }
        const unsigned old = xb_add(&bar[XB_XSUB(b.x)], 1u);
        const unsigned gen = old / nloc;
        if (old + 1u == (gen + 1u) * nloc) {
            __builtin_amdgcn_fence(__ATOMIC_RELEASE, "agent");
            asm volatile("s_waitcnt vmcnt(0)" ::: "memory");
            const unsigned og = xb_add(&bar[XB_TOP], 1u);
            const unsigned tg = og / nx;
            if (og + 1u == (tg + 1u) * nx) {
#pragma unroll
                for (unsigned j = 0; j < 16; ++j) xb_add(&bar[XB_XGEN(j)], 1u); }
            else XB_SPIN(xb_ld(&bar[XB_XGEN(b.x)]) == gen, bar);
            asm volatile("s_waitcnt vmcnt(0)" ::: "memory");
        } else {
            XB_SPIN(xb_ld(&bar[XB_XGEN(b.x)]) == gen, bar);
            asm volatile("s_waitcnt vmcnt(0)" ::: "memory");
        }
    }
    __syncthreads();
}

struct Ptrs {
    const float* in[25]; float* out; unsigned char* ws;
};
typedef const float* kfptr_t;
__device__ __forceinline__ const float* kin(int i) { const __attribute__((address_space(4))) kfptr_t* kp = (const __attribute__((address_space(4))) kfptr_t*)__builtin_amdgcn_kernarg_segment_ptr(); asm volatile("" : "+s"(i)); return kp[i]; }
__device__ __forceinline__ float* kout() { return (float*)kin(25); }
__device__ __forceinline__ unsigned char* kws() { return (unsigned char*)kin(26); }
__device__ __forceinline__ unsigned char* pg8::kws_() { return kws(); }
__device__ __forceinline__ int gu_row(int j, int ty) { return 256 * (j >> 7) + 128 * ((j >> 2) & 1) + 32 * ((j >> 5) & 3) + 16 * ty + 4 * ((j >> 3) & 3) + (j & 3); }

struct TrItem { const float* W; bf16* WT; const float* gk; int ldw, nblk, ldt, ty, r; float cm; };
__device__ __forceinline__ void tr_load(const TrItem& t, f32x4 (&v)[16], int lane) {
    const int kb = t.r / t.nblk, nb = t.r - kb * t.nblk;
    const float* src = t.W + (size_t)(64 * kb + (lane >> 4)) * t.ldw + 64 * nb + 4 * (lane & 15);
#pragma unroll
    for (int i = 0; i < 16; ++i) v[i] = __builtin_nontemporal_load((const f32x4*)(src + (size_t)(4 * i) * t.ldw));
}
__device__ __forceinline__ void tr_finish(const TrItem& t, const f32x4 (&v)[16], LAS float* scr, int lane) {
    const int kb = t.r / t.nblk, nb = t.r - kb * t.nblk, k0 = 64 * kb, n0 = 64 * nb;
#pragma unroll
    for (int i = 0; i < 16; ++i) { const int kk = (lane >> 4) + 4 * i; *(LAS f32x4*)(scr + kk * 64 + ((4 * (lane & 15)) ^ (8 * ((kk >> 3) & 3)))) = v[i]; }
    LDS_WAIT(); asm volatile("" ::: "memory");
    {
    const int c = lane >> 3, nl = lane & 7;
    float gs[8];
#pragma unroll
    for (int e = 0; e < 8; ++e) gs[e] = t.cm * (t.gk ? t.gk[k0 + 8 * c + e] : 1.0f);
#pragma unroll
    for (int j = 0; j < 8; ++j) { const int n = nl + 8 * j; const LAS float* sp = scr + (8 * c) * 64 + (n ^ (8 * (c & 3)));
        u32x4 o; o.x = pk2(sp[0 * 64] * gs[0], sp[1 * 64] * gs[1]); o.y = pk2(sp[2 * 64] * gs[2], sp[3 * 64] * gs[3]); o.z = pk2(sp[4 * 64] * gs[4], sp[5 * 64] * gs[5]); o.w = pk2(sp[6 * 64] * gs[6], sp[7 * 64] * gs[7]);
        const int dr = t.ty < 0 ? (n0 + n) : gu_row(n0 + n, t.ty);
        *(u32x4*)(t.WT + (size_t)dr * t.ldt + k0 + 8 * c) = o; }
    }
    LDS_WAIT(); asm volatile("" ::: "memory");
}
__device__ __forceinline__ TrItem pro_item(int q, unsigned char* ws) {
    TrItem t; t.cm = 1.0f;
    if (q < 896) { const int l = q / 448; int r = q - l * 448;
        if (r < 128) { t.W = kin(2) + (size_t)l * D * D; t.ldw = D; t.nblk = 8; t.WT = (bf16*)(ws + WS_WIN) + (size_t)l * D * D; t.ldt = D; t.gk = kin(1) + l * D; t.ty = -1; t.r = r; return t; } r -= 128;
        if (r < 64) { t.W = kin(11) + (size_t)l * 512 * 512; t.ldw = 512; t.nblk = 8; t.WT = (bf16*)(ws + WS_WGLU) + (size_t)l * 512 * 512; t.ldt = 512; t.gk = nullptr; t.ty = -1; t.r = r; t.cm = -1.4426950408889634f; return t; } r -= 64;
        t.W = kin(15) + (size_t)l * D * D; t.ldw = D; t.nblk = 16; t.WT = (bf16*)(ws + WS_WOUT) + (size_t)l * D * D; t.ldt = D; t.gk = nullptr; t.ty = -1; t.r = r; return t; }
    const int qq = q - 896, mi = qq / 704; t.r = qq - mi * 704;
    if (mi == 2) { t.W = kin(19); t.ldw = D; t.nblk = 16; t.WT = (bf16*)(ws + WS_WD); t.ldt = DFF; t.gk = nullptr; t.ty = -1; }
    else { t.W = mi == 0 ? kin(17) : kin(18); t.ldw = DFF; t.nblk = 44; t.WT = (bf16*)(ws + WS_WGU); t.ldt = D; t.gk = kin(16); t.ty = mi; t.cm = mi == 0 ? -1.4426950408889634f : -2.772588722239781f; }
    return t;
}
__device__ __forceinline__ void tr_run(unsigned char* ws, LAS float* scr, int first, int step, int it1, int lane) {
    int it = first; if (it >= it1) return;
    TrItem cur = pro_item(it, ws); f32x4 vc[16]; tr_load(cur, vc, lane);
    for (;;) { const int nx = it + step; const bool more = nx < it1; TrItem nxt = cur; f32x4 vn[16];
        if (more) { nxt = pro_item(nx, ws); tr_load(nxt, vn, lane); }
        tr_finish(cur, vc, scr, lane);
        if (!more) break;
        cur = nxt; it = nx;
#pragma unroll
        for (int i = 0; i < 16; ++i) vc[i] = vn[i]; }
}

__device__ __forceinline__ void ssm_tables_item(int item, LAS unsigned char* lds, int tid) {
    const int lh = item >> 2, q = item & 3;
    LAS float* lp_re = (LAS float*)lds;
    LAS float* lp_im = lp_re + 17 * 64;
    LAS float* cf_re = lp_im + 17 * 64;
    LAS float* cf_im = cf_re + 64;
    LAS float* bb_re = cf_im + 64;
    LAS float* bb_im = bb_re + 1024;
    LAS float* Kt = bb_im + 1024;
    LAS float* cq_re = Kt + 1024;
    LAS float* cq_im = cq_re + 256;
    const float dt = expf(kin(3)[lh]);
    const float* a_re = kin(4) + (size_t)lh * 64; const float* a_im = kin(5) + (size_t)lh * 64;
    const float* b_re = kin(6) + (size_t)lh * 1024; const float* b_im = kin(7) + (size_t)lh * 1024;
    const float* c_re = kin(8) + (size_t)lh * 1024 + q * 256; const float* c_im = kin(9) + (size_t)lh * 1024 + q * 256;
    const float* dd = kin(10) + (size_t)lh * 16;
    bf16* TW = (bf16*)(kws() + WS_TW) + (size_t)lh * 256 * UZK;
    bf16* WE = (bf16*)(kws() + WS_WE) + (size_t)lh * 256 * 256;
    float* LT = (float*)(kws() + WS_LAMT) + (size_t)lh * 128;
    __syncthreads();
    for (int idx = tid; idx < 17 * 64; idx += 512) {
        const int k = idx >> 6, p = idx & 63;
        const float ar = fminf(a_re[p], -1e-4f), ai = a_im[p];
        const float mag = expf(ar * dt * (float)k);
        double rev = (double)ai * (double)dt * (double)k * 0.15915494309189535; rev -= floor(rev);
        const float ang = (float)(rev * 6.283185307179586);
        const float sn = sinf(ang), cs = cosf(ang);
        lp_re[idx] = mag * cs; lp_im[idx] = mag * sn;
        if (k == 1) { const float lr = mag * cs, li = mag * sn, den = ar * ar + ai * ai, nr = lr - 1.0f, ni = li;
            cf_re[p] = (nr * ar + ni * ai) / den; cf_im[p] = (ni * ar - nr * ai) / den; }
        if (k == 16 && q == 0) { LT[2 * p] = mag * cs; LT[2 * p + 1] = mag * sn; }
    }
    if (tid < 256) { cq_re[tid] = c_re[tid]; cq_im[tid] = c_im[tid]; }
    __syncthreads();
    for (int idx = tid; idx < 1024; idx += 512) { const int p = idx >> 4; const float br = b_re[idx], bi = b_im[idx], cr = cf_re[p], ci = cf_im[p];
        bb_re[idx] = cr * br - ci * bi; bb_im[idx] = cr * bi + ci * br; }
    __syncthreads();
    if (tid < 256) { const int k = tid >> 4, gl = (tid >> 2) & 3, g4 = tid & 3; f32x4 s = (f32x4){0.f, 0.f, 0.f, 0.f};
#pragma unroll 2
        for (int p0 = 0; p0 < 64; p0 += 4) { const f32x4 cr4 = *(const LAS f32x4*)(cq_re + gl * 64 + p0), ci4 = *(const LAS f32x4*)(cq_im + gl * 64 + p0), wr4 = *(const LAS f32x4*)(lp_re + k * 64 + p0), wi4 = *(const LAS f32x4*)(lp_im + k * 64 + p0);
#pragma unroll
            for (int j = 0; j < 4; ++j) { const float xr = cr4[j] * wr4[j] - ci4[j] * wi4[j], xi = cr4[j] * wi4[j] + ci4[j] * wr4[j];
                const f32x4 br = *(const LAS f32x4*)(bb_re + (p0 + j) * 16 + 4 * g4), bi = *(const LAS f32x4*)(bb_im + (p0 + j) * 16 + 4 * g4); s += xr * br - xi * bi; } }
        if (k == 0 && ((4 * q + gl) >> 2) == g4) s[(4 * q + gl) & 3] += dd[4 * q + gl];
        *(LAS f32x4*)(Kt + k * 64 + gl * 16 + 4 * g4) = s; }
    __syncthreads();
    for (int ch = tid; ch < 64 * 48; ch += 512) { const int nr = ch / 48, cc = ch - nr * 48, j = nr >> 2, gl = nr & 3, n = j * 16 + 4 * q + gl, col8 = cc * 8; float v[8];
        if (col8 < 256) { const int i = col8 >> 4, gi0 = col8 & 15;
#pragma unroll
            for (int e = 0; e < 8; ++e) v[e] = (i <= j) ? Kt[((j - i) * 4 + gl) * 16 + gi0 + e] : 0.f; }
        else {
#pragma unroll
            for (int e = 0; e < 8; ++e) { const int pp = col8 - 256 + e, p = pp & 63; const float cr = cq_re[gl * 64 + p], ci = cq_im[gl * 64 + p], wr_ = lp_re[(j + 1) * 64 + p], wi = lp_im[(j + 1) * 64 + p];
                v[e] = pp < 64 ? (cr * wr_ - ci * wi) : -(cr * wi + ci * wr_); } }
        u32x4 o; o.x = pk2(v[0], v[1]); o.y = pk2(v[2], v[3]); o.z = pk2(v[4], v[5]); o.w = pk2(v[6], v[7]);
        *(u32x4*)(TW + (size_t)n * UZK + col8) = o; }
    for (int ch = tid; ch < 32 * 32; ch += 512) { const int pr = 32 * q + (ch >> 5), cc = ch & 31, col8 = cc * 8, i = col8 >> 4, g0 = col8 & 15, p = pr & 63; float v[8];
        const float wr_ = lp_re[(15 - i) * 64 + p], wi = lp_im[(15 - i) * 64 + p];
#pragma unroll
        for (int e = 0; e < 8; ++e) { const float br = bb_re[p * 16 + g0 + e], bi = bb_im[p * 16 + g0 + e]; v[e] = pr < 64 ? (wr_ * br - wi * bi) : (wr_ * bi + wi * br); }
        u32x4 o; o.x = pk2(v[0], v[1]); o.y = pk2(v[2], v[3]); o.z = pk2(v[4], v[5]); o.w = pk2(v[6], v[7]);
        *(u32x4*)(WE + (size_t)pr * 256 + col8) = o; }
    __syncthreads();
}

__device__ __forceinline__ void pool_fold_item_rolled(const Ptrs& P, int it, LAS float* scr, int lane) {
    const int l = it >> 9, grp = (it >> 7) & 3, kb = (it >> 3) & 15, db = it & 7, k = 64 * kb + lane;
    const f32x4* row = (const f32x4*)(kin(2) + ((size_t)l * D + k) * D + 512 + 128 * grp);
    const float* pw = kin(13) + ((size_t)(l * 4 + grp) * 128) * 128 + 16 * db;
    f32x4 pv[8];
#pragma unroll
    for (int i = 0; i < 8; ++i) { const int i4 = lane + 64 * i; pv[i] = *(const f32x4*)(pw + (size_t)(i4 >> 2) * 128 + 4 * (i4 & 3)); }
    f32x4 cur[4];
#pragma unroll
    for (int i = 0; i < 4; ++i) cur[i] = row[i];
#pragma unroll
    for (int i = 0; i < 8; ++i) *(LAS f32x4*)(scr + 4 * (lane + 64 * i)) = pv[i];
    LDS_WAIT(); asm volatile("" ::: "memory");
    float acc[16];
#pragma unroll
    for (int d = 0; d < 16; ++d) acc[d] = 0.f;
#pragma unroll 1
    for (int g = 0; g < 8; ++g) { f32x4 nxt[4];
#pragma unroll
        for (int i = 0; i < 4; ++i) nxt[i] = row[4 * ((g + 1) & 7) + i];
#pragma unroll
        for (int i = 0; i < 4; ++i)
#pragma unroll
            for (int cc = 0; cc < 4; ++cc) { const LAS f32x4* pr = (const LAS f32x4*)(scr + (4 * (4 * g + i) + cc) * 16);
#pragma unroll
                for (int d4 = 0; d4 < 4; ++d4) { const f32x4 pq = pr[d4];
#pragma unroll
                    for (int d = 0; d < 4; ++d) acc[4 * d4 + d] += cur[i][cc] * pq[d]; }
                __builtin_amdgcn_sched_barrier(0); }
#pragma unroll
        for (int i = 0; i < 4; ++i) cur[i] = nxt[i]; }
    LDS_WAIT(); asm volatile("" ::: "memory");
    const float gk = kin(1)[l * D + k];
    bf16* WT = (bf16*)(kws() + WS_WIN) + (size_t)l * D * D;
#pragma unroll
    for (int d = 0; d < 16; ++d) { const int dl = 128 * grp + 16 * db + d; WT[(size_t)(512 + dl) * D + k] = (bf16)f2bf(acc[d] * gk * kin(14)[l * DPOOL + dl]); }
}

__device__ __forceinline__ void pool_fold_item(const Ptrs& P, int it, LAS float* scr, int lane) {
    const int l = it >> 9, grp = (it >> 7) & 3, kb = (it >> 3) & 15, db = it & 7, k = 64 * kb + lane;
    const f32x4* row = (const f32x4*)(kin(2) + ((size_t)l * D + k) * D + 512 + 128 * grp);
    const float* pw = kin(13) + ((size_t)(l * 4 + grp) * 128) * 128 + 16 * db;
    f32x4 a[32], pv[8];
#pragma unroll
    for (int i = 0; i < 8; ++i) { const int i4 = lane + 64 * i; pv[i] = *(const f32x4*)(pw + (size_t)(i4 >> 2) * 128 + 4 * (i4 & 3)); }
#pragma unroll
    for (int i = 0; i < 32; ++i) a[i] = row[i];
#pragma unroll
    for (int i = 0; i < 8; ++i) *(LAS f32x4*)(scr + 4 * (lane + 64 * i)) = pv[i];
    LDS_WAIT(); asm volatile("" ::: "memory");
    float acc[16];
#pragma unroll
    for (int d = 0; d < 16; ++d) acc[d] = 0.f;
#pragma unroll
    for (int i = 0; i < 32; ++i)
#pragma unroll
        for (int cc = 0; cc < 4; ++cc) { const LAS f32x4* pr = (const LAS f32x4*)(scr + (4 * i + cc) * 16);
#pragma unroll
            for (int d4 = 0; d4 < 4; ++d4) { const f32x4 pq = pr[d4];
#pragma unroll
                for (int d = 0; d < 4; ++d) acc[4 * d4 + d] += a[i][cc] * pq[d]; } }
    LDS_WAIT(); asm volatile("" ::: "memory");
    const float gk = kin(1)[l * D + k];
    bf16* WT = (bf16*)(kws() + WS_WIN) + (size_t)l * D * D;
#pragma unroll
    for (int d = 0; d < 16; ++d) { const int dl = 128 * grp + 16 * db + d; WT[(size_t)(512 + dl) * D + k] = (bf16)f2bf(acc[d] * gk * kin(14)[l * DPOOL + dl]); }
}

__device__ __forceinline__ void xrow_item(const float* xrow, bf16* orow, float* srow, int lane) {
    const f32x4* xr = (const f32x4*)xrow + lane; f32x4 v[4]; float s = 0.f;
#pragma unroll
    for (int j = 0; j < 4; ++j) { v[j] = xr[64 * j]; s += (v[j][0] * v[j][0] + v[j][1] * v[j][1]) + (v[j][2] * v[j][2] + v[j][3] * v[j][3]); }
    s = wave_sum(s, lane);
    u32x2* o8 = (u32x2*)orow + lane;
#pragma unroll
    for (int j = 0; j < 4; ++j) { u32x2 w; w.x = pk2(v[j][0], v[j][1]); w.y = pk2(v[j][2], v[j][3]); o8[64 * j] = w; }
    if (lane < 16) srow[lane] = lane == 0 ? s : 0.f;
}

struct Ids { int tid, lane, wave, G, bx, gw, NGW; };
__device__ __forceinline__ int hw_lane() { int l; asm volatile("v_mbcnt_lo_u32_b32 %0, -1, 0\n\tv_mbcnt_hi_u32_b32 %0, -1, %0" : "=v"(l)); return l; }
__device__ __forceinline__ Ids make_ids(int wave) {
    asm volatile("" : "+s"(wave));
    Ids I; I.lane = hw_lane(); I.wave = wave; I.tid = wave * 64 + I.lane; I.G = gridDim.x; I.bx = blockIdx.x;
    const int vcu = (I.G % 8 == 0) ? (I.bx % 8) * (I.G / 8) + I.bx / 8 : I.bx;
    I.gw = vcu * NWAVES + I.wave; I.NGW = I.G * NWAVES; return I;
}

constexpr int XT_TAB = 0, XT_OTH = 4;
__device__ __forceinline__ void p0_prologue(const Ptrs& P, LAS unsigned char* lds, int wave) {
    const Ids I = make_ids(wave); unsigned char* ws = kws();
    for (int it = I.bx; it < 128; it += I.G) ssm_tables_item(it, lds, I.tid);
    __syncthreads();
    LAS float* scr = (LAS float*)(lds + I.wave * 16384);
    if (I.G == 256) { if (I.bx < 128) { if (I.wave < 4) pool_fold_item_rolled(P, I.wave * 128 + I.bx, scr, I.lane); else if (I.wave == 4) tr_run(ws, scr, I.bx, 128, 128, I.lane); } }
    else { tr_run(ws, scr, I.gw, I.NGW, 128, I.lane); for (int it = I.gw; it < 512; it += I.NGW) pool_fold_item(P, it, scr, I.lane); }
    const bool bal = I.G == 256; const int wv = I.bx * NWAVES + I.wave, ntr = bal ? (I.bx < 128 ? XT_TAB : XT_OTH) : (M / 4 + I.NGW - 1) / I.NGW;
#define XP_TRIP(tq) (bal ? (I.bx < 128 ? wv * XT_TAB + (tq) : 1024 * XT_TAB + (wv - 1024) * XT_OTH + (tq)) : wv + (tq) * I.NGW)
#define XP_LOAD(v, trip) do { const int m0_ = 4 * (trip); _Pragma("unroll") for (int r = 0; r < 4; ++r) { const f32x4* xr = (const f32x4*)(kin(0) + (size_t)(m0_ + r) * D) + I.lane; \
        _Pragma("unroll") for (int j = 0; j < 4; ++j) v[r][j] = __builtin_nontemporal_load(xr + 64 * j); } } while (0)
#define XP_DO(v, trip) do { const int m0_ = 4 * (trip); _Pragma("unroll") for (int r = 0; r < 4; ++r) { const int m = m0_ + r; float sq = 0.f; \
        _Pragma("unroll") for (int j = 0; j < 4; ++j) sq += (v[r][j][0] * v[r][j][0] + v[r][j][1] * v[r][j][1]) + (v[r][j][2] * v[r][j][2] + v[r][j][3] * v[r][j][3]); \
        sq = wave_sum(sq, I.lane); u32x2* o8 = (u32x2*)((bf16*)(ws + WS_XB) + (size_t)m * D) + I.lane; \
        _Pragma("unroll") for (int j = 0; j < 4; ++j) { u32x2 w; w.x = pk2(v[r][j][0], v[r][j][1]); w.y = pk2(v[r][j][2], v[r][j][3]); o8[64 * j] = w; } \
        if (I.lane < 16) ((float*)(ws + WS_STATS))[(size_t)m * 16 + I.lane] = I.lane == 0 ? sq : 0.f; } } while (0)
    f32x4 va[4][4], vb[4][4];
    if (ntr > 0 && XP_TRIP(0) < M / 4) XP_LOAD(va, XP_TRIP(0));
    for (int tq = 0; tq < ntr; tq += 2) { const int t0 = XP_TRIP(tq), t1 = XP_TRIP(tq + 1), t2 = XP_TRIP(tq + 2); if (t0 >= M / 4) break;
        const bool h1 = tq + 1 < ntr && t1 < M / 4, h2 = tq + 2 < ntr && t2 < M / 4;
        if (h1) XP_LOAD(vb, t1);
        XP_DO(va, t0);
        if (!h1) break;
        if (h2) XP_LOAD(va, t2);
        XP_DO(vb, t1); }
#undef XP_TRIP
#undef XP_LOAD
#undef XP_DO
}

constexpr int MOE_TILES = 24 * 88;
struct MoeTile { const float* src; unsigned char* dst; const float* gk; int ldw, ldt, k0, n0, ty; };
__device__ __forceinline__ MoeTile moe_tile(int tile, unsigned char* ws) {
    MoeTile t;
    if (tile >= MOE_TILES) { const int r = tile - MOE_TILES, kb = r >> 2, nb = r & 3; t.ldw = D; t.src = kin(19) + (size_t)(kb * 128) * D + nb * 256; t.dst = ws + WS_WD; t.ldt = DFF; t.k0 = kb * 128; t.n0 = nb * 256; t.ty = -1; t.gk = nullptr; return t; }
    int e, kind, r; if (tile < 1408) { const int mi = tile / 88; r = tile - mi * 88; e = mi >> 1; kind = mi & 1; } else { const int d = tile - 1408; e = d / 88; r = d - e * 88; kind = 2; }
    if (kind == 2) { const int kb = r >> 2, nb = r & 3; t.ldw = D; t.src = kin(23) + (size_t)e * DFF * D + (size_t)(kb * 128) * D + nb * 256; t.dst = ws + WS_MWD + (size_t)e * D * DFF; t.ldt = DFF; t.k0 = kb * 128; t.n0 = nb * 256; t.ty = -1; t.gk = nullptr; }
    else { const int kb = r / 11, nb = r - kb * 11; t.ldw = DFF; t.src = (kind == 0 ? kin(21) : kin(22)) + (size_t)e * D * DFF + (size_t)(kb * 128) * DFF + nb * 256; t.dst = ws + WS_MWGU + (size_t)e * 2 * DFF * D; t.ldt = D; t.k0 = kb * 128; t.n0 = nb * 256; t.ty = kind; t.gk = kin(16) + D; }
    return t;
}
__device__ __forceinline__ void moe_convert_wg(LAS unsigned char* lds, int wave, int frank, int nf, int t0, int t1) {
    const Ids I = make_ids(wave); unsigned char* ws = kws(); LAS float* tl = (LAS float*)lds; const int lane = I.lane, w = I.wave;
    int tile = t0 + frank; if (tile >= t1) return;
    MoeTile cur = moe_tile(tile, ws); f32x4 v[16];
#pragma unroll
    for (int i = 0; i < 16; ++i) v[i] = __builtin_nontemporal_load((const f32x4*)(cur.src + (size_t)(16 * w + i) * cur.ldw + 4 * lane));
    for (;;) {
        __syncthreads();
#pragma unroll
        for (int i = 0; i < 16; ++i) { const int k = 16 * w + i; *(LAS f32x4*)(tl + k * 256 + ((4 * lane) ^ (4 * ((k >> 4) & 7)))) = v[i]; }
        LDS_WAIT(); __syncthreads();
        const int nx = tile + nf; const bool more = nx < t1; const MoeTile t = cur;
        if (more) { cur = moe_tile(nx, ws);
#pragma unroll
            for (int i = 0; i < 16; ++i) v[i] = __builtin_nontemporal_load((const f32x4*)(cur.src + (size_t)(16 * w + i) * cur.ldw + 4 * lane)); }
        const int c = lane & 7, nl = lane >> 3; float gs[16];
        const float cm = t.ty == 0 ? -64.f * 1.4426950408889634f : t.ty == 1 ? -64.f * 2.772588722239781f : 64.f;
#pragma unroll
        for (int e = 0; e < 16; ++e) gs[e] = cm * (t.gk ? t.gk[t.k0 + 16 * c + e] : 1.0f);
#pragma unroll
        for (int j = 0; j < 4; ++j) { const int n = 32 * w + 8 * j + nl; const LAS float* sp = tl + (16 * c) * 256 + (n ^ (4 * c));
            u32x4 o; o.x = pk4_fp8(gs[0] * sp[0 * 256], gs[1] * sp[1 * 256], gs[2] * sp[2 * 256], gs[3] * sp[3 * 256]); o.y = pk4_fp8(gs[4] * sp[4 * 256], gs[5] * sp[5 * 256], gs[6] * sp[6 * 256], gs[7] * sp[7 * 256]);
            o.z = pk4_fp8(gs[8] * sp[8 * 256], gs[9] * sp[9 * 256], gs[10] * sp[10 * 256], gs[11] * sp[11 * 256]); o.w = pk4_fp8(gs[12] * sp[12 * 256], gs[13] * sp[13 * 256], gs[14] * sp[14 * 256], gs[15] * sp[15 * 256]);
            const int dr = t.ty < 0 ? (t.n0 + n) : gu_row(t.n0 + n, t.ty);
            *(u32x4*)(t.dst + (size_t)dr * t.ldt + t.k0 + 16 * c) = o; }
        if (!more) break;
        tile = nx;
    }
    LDS_WAIT(); __syncthreads();
}

constexpr int MF_A = 256, MF_B = MF_A + 0, MF_C = MF_B + 512, MF_D = MF_C + 384;
constexpr int MT_RT = 128;
constexpr int MT_POS = 224;
constexpr int MT_TAIL = 336, MT_END = MOE_TILES - MT_TAIL;
static_assert(MF_D < MT_END && MT_END >= 1408, "filler slots");
constexpr int PRO_SPLIT = 1280;
__device__ __forceinline__ void pro_convert(LAS unsigned char* lds, int wave, int frank, int nf, int it0 = 128, int it1 = 896 + 2 * 704) {
    const Ids I = make_ids(wave); unsigned char* ws = kws(); LAS float* scr = (LAS float*)(lds + I.wave * 16384);
    tr_run(ws, scr, it0 + frank * NWAVES + I.wave, nf * NWAVES, it1, I.lane);
}
__device__ __forceinline__ void misc_fill(const Ptrs& P, LAS unsigned char* lds, int wave, int frank, int nf) {
    const Ids I = make_ids(wave);
    for (int it = 128 + frank; it < 256; it += nf) ssm_tables_item(it, lds, I.tid);
    __syncthreads();
    LAS float* scr = (LAS float*)(lds + I.wave * 16384);
    if (nf == 128) { if (I.wave < 3) pool_fold_item_rolled(P, 512 + I.wave * 128 + frank, scr, I.lane); }
    else for (int it = 512 + frank * NWAVES + I.wave; it < 1024; it += nf * NWAVES) pool_fold_item(P, it, scr, I.lane);
}

template <int W> __device__ __forceinline__ void pool_task(const bf16* VB, bf16* MIXED, int g, int run4, int lane) {
    asm volatile("" : "+v"(lane));
    const int run = 4 * run4 + (lane >> 4), c8 = 128 * g + 8 * (lane & 15), t0 = 16 * run, tin0 = t0 & (SEQ - 1);
    const bf16* vp = VB + (size_t)t0 * DPOOL + c8;
    u32x4 v[W - 1 + 16];
#pragma unroll
    for (int i = 0; i < W - 1 + 16; ++i) { const int r = i - (W - 1); v[i] = (tin0 + r >= 0) ? *(const u32x4*)(vp + (ptrdiff_t)r * DPOOL) : (u32x4){0u, 0u, 0u, 0u}; }
    float s[8];
#pragma unroll
    for (int e = 0; e < 8; ++e) s[e] = 0.f;
#pragma unroll
    for (int i = 0; i < W - 1; ++i) { s[0] += bf_lo(v[i].x); s[1] += bf_hi(v[i].x); s[2] += bf_lo(v[i].y); s[3] += bf_hi(v[i].y); s[4] += bf_lo(v[i].z); s[5] += bf_hi(v[i].z); s[6] += bf_lo(v[i].w); s[7] += bf_hi(v[i].w); }
#pragma unroll
    for (int j = 0; j < 16; ++j) { const u32x4 c = v[W - 1 + j]; const float x[8] = {bf_lo(c.x), bf_hi(c.x), bf_lo(c.y), bf_hi(c.y), bf_lo(c.z), bf_hi(c.z), bf_lo(c.w), bf_hi(c.w)};
#pragma unroll
        for (int e = 0; e < 8; ++e) s[e] += x[e];
        const int cnt = tin0 + j + 1 < W ? tin0 + j + 1 : W; const float rc = 1.0f / (float)cnt; u32x4 o;
        o.x = pk2(s[0] * rc - x[0], s[1] * rc - x[1]); o.y = pk2(s[2] * rc - x[2], s[3] * rc - x[3]); o.z = pk2(s[4] * rc - x[4], s[5] * rc - x[5]); o.w = pk2(s[6] * rc - x[6], s[7] * rc - x[7]);
        *(u32x4*)(MIXED + (size_t)(t0 + j) * D + 512 + c8) = o;
        const u32x4 d = v[j];
        s[0] -= bf_lo(d.x); s[1] -= bf_hi(d.x); s[2] -= bf_lo(d.y); s[3] -= bf_hi(d.y); s[4] -= bf_lo(d.z); s[5] -= bf_hi(d.z); s[6] -= bf_lo(d.w); s[7] -= bf_hi(d.w); }
}
__device__ __forceinline__ void pool_filter(int wave, int prank, int pn) {
    const Ids I = make_ids(wave); const bf16* VB = (const bf16*)(kws() + WS_V); bf16* MIXED = (bf16*)(kws() + WS_MIXED);
    for (int task = prank * NWAVES + I.wave; task < 4 * (M / 64); task += pn * NWAVES) { const int g = task & 3, run4 = task >> 2;
        if (g == 0) pool_task<2>(VB, MIXED, 0, run4, I.lane); else if (g == 1) pool_task<4>(VB, MIXED, 1, run4, I.lane);
        else if (g == 2) pool_task<8>(VB, MIXED, 2, run4, I.lane); else pool_task<16>(VB, MIXED, 3, run4, I.lane); }
}

__device__ __forceinline__ void scan_unit(int l, int un, LAS unsigned char* lds, int wave) {
    const Ids I = make_ids(wave); const int lane = I.lane, h = un >> 2, pm = un & 3, bb = I.wave >> 2, sg = I.wave & 3;
    const float* LT = (const float*)(kws() + WS_LAMT) + (size_t)(l * NH + h) * 128; const float ltr = LT[2 * lane], lti = LT[2 * lane + 1];
    const size_t row0 = (size_t)h * NR + pm * 256 + bb * 128 + sg * 32;
    const float* eb = (const float*)(kws() + WS_E) + row0 * 128; bf16* zb = (bf16*)(kws() + WS_UZ) + row0 * UZK + 256;
    LAS float* xch = (LAS float*)lds;
    float zr[32], zi[32], er = 0.f, ei = 0.f;
    {   float a[32], b[32];
#pragma unroll
        for (int i = 0; i < 32; ++i) { a[i] = __builtin_nontemporal_load(eb + (size_t)i * 128 + lane); b[i] = __builtin_nontemporal_load(eb + (size_t)i * 128 + 64 + lane); }
#pragma unroll
        for (int i = 0; i < 32; ++i) { zr[i] = er; zi[i] = ei; const float nr = ltr * er - lti * ei + a[i], ni = ltr * ei + lti * er + b[i]; er = nr; ei = ni; } }
    xch[I.wave * 128 + lane] = er; xch[I.wave * 128 + 64 + lane] = ei;
    float pr = ltr, pi = lti;
#pragma unroll
    for (int q = 0; q < 5; ++q) { const float nr = pr * pr - pi * pi, ni = 2.f * pr * pi; pr = nr; pi = ni; }
    LDS_WAIT(); __syncthreads();
    float cr = 0.f, ci = 0.f;
    for (int s2 = 0; s2 < sg; ++s2) { const float xr = xch[(bb * 4 + s2) * 128 + lane], xi = xch[(bb * 4 + s2) * 128 + 64 + lane]; const float nr = pr * cr - pi * ci + xr, ni = pr * ci + pi * cr + xi; cr = nr; ci = ni; }
    float wr_ = 1.f, wi = 0.f;
#pragma unroll
    for (int i = 0; i < 32; ++i) { const float fr = zr[i] + wr_ * cr - wi * ci, fi = zi[i] + wr_ * ci + wi * cr;
        zb[(size_t)i * UZK + lane] = (bf16)f2bf(fr); zb[(size_t)i * UZK + 64 + lane] = (bf16)f2bf(fi);
        const float nr = wr_ * ltr - wi * lti, ni = wr_ * lti + wi * ltr; wr_ = nr; wi = ni; }
    LDS_WAIT(); __syncthreads();
}
__device__ __forceinline__ void wg_publish_local(bool t0, bool inv) {
    asm volatile("s_waitcnt vmcnt(0)" ::: "memory"); __syncthreads();
    if (inv) { if (t0) { __builtin_amdgcn_fence(__ATOMIC_ACQUIRE, "agent"); asm volatile("s_waitcnt vmcnt(0)" ::: "memory"); }
               __syncthreads(); }
}

constexpr int RT_LD = 2064;
__device__ __forceinline__ void routing_phase(const Ptrs& P, LAS unsigned char* lds, int wave, const bool packed = false  ) {
    const Ids I = make_ids(wave); const int lane = I.lane, fr = lane & 15, fq = lane >> 4; unsigned char* ws = kws();
    u32x4* TOK = (u32x4*)(ws + WS_TOK); int* CNT = (int*)(ws + WS_CNT); LAS int* lcnt = (LAS int*)(lds + 16 * RT_LD);
    const bool act = packed || I.wave < 4; const int g0_ = packed ? 2 * I.bx : I.bx;
    for (int grp0 = g0_; grp0 < M / 64; grp0 += packed ? M / 64 : I.G) { const int grp = grp0 + (packed ? (I.wave >> 2) : 0);
        bf16x8 a[32];
        const int m = 64 * grp + 16 * (I.wave & 3) + fr;
        if (act) { const bf16x8* xr = (const bf16x8*)((const bf16*)(ws + WS_XB) + (size_t)m * D + 256 * fq);
#pragma unroll
            for (int s_ = 0; s_ < 32; ++s_) a[s_] = xr[s_]; }
        if (grp0 == g0_) {
            float wv[2][8], gkv[2];
#pragma unroll
            for (int h = 0; h < 2; ++h) { const int k = I.tid + 512 * h; const f32x4 r0 = *(const f32x4*)(kin(20) + (size_t)k * 8), r1 = *(const f32x4*)(kin(20) + (size_t)k * 8 + 4); gkv[h] = kin(16)[D + k];
#pragma unroll
                for (int e = 0; e < 4; ++e) { wv[h][e] = r0[e]; wv[h][4 + e] = r1[e]; } }
#pragma unroll
            for (int h = 0; h < 2; ++h) { const int k = I.tid + 512 * h;
#pragma unroll
                for (int e = 0; e < 8; ++e) { const float w = gkv[h] * wv[h][e]; const unsigned hi = f2bf(w); const float rest = w - u2f(hi << 16);
                    *(LAS unsigned short*)(lds + e * RT_LD + 2 * k) = (unsigned short)hi; *(LAS unsigned short*)(lds + (8 + e) * RT_LD + 2 * k) = (unsigned short)f2bf(rest); } }
        }
        LDS_WAIT(); __syncthreads();
        if (act) {
            f32x4 acc = (f32x4){0.f, 0.f, 0.f, 0.f}, sq = (f32x4){0.f, 0.f, 0.f, 0.f};
            const LAS unsigned char* bp = lds + fr * RT_LD + 512 * fq;
#pragma unroll
            for (int s_ = 0; s_ < 32; ++s_) { const bf16x8 b = *(const LAS bf16x8*)(bp + 16 * s_);
                acc = __builtin_amdgcn_mfma_f32_16x16x32_bf16(b, a[s_], acc, 0, 0, 0); sq = __builtin_amdgcn_mfma_f32_16x16x32_bf16(a[s_], a[s_], sq, 0, 0, 0); }
            float ssd = (fr & 3) == 0 ? sq[0] : (fr & 3) == 1 ? sq[1] : (fr & 3) == 2 ? sq[2] : sq[3];
            const float ss = __builtin_bit_cast(float, __builtin_amdgcn_ds_bpermute((fr + 16 * (fr >> 2)) << 2, __builtin_bit_cast(int, ssd)));
            const float inv = 1.0f / sqrtf(ss * (1.0f / D) + RMS_EPS);
            float pl[4];
#pragma unroll
            for (int q = 0; q < 4; ++q) pl[q] = (acc[q] + shx(acc[q], lane, 32)) * inv;
            const int eb = 4 * (fq & 1); float v0 = pl[0], v1 = -3.0e38f; int e0 = eb, e1 = -1;
#pragma unroll
            for (int q = 1; q < 4; ++q) { const float v = pl[q]; const int e = eb + q;
                if (v > v0) { v1 = v0; e1 = e0; v0 = v; e0 = e; } else if (v > v1) { v1 = v; e1 = e; } }
            { const float ov0 = shx(v0, lane, 16), ov1 = shx(v1, lane, 16); const int oe0 = __builtin_amdgcn_ds_bpermute((lane ^ 16) << 2, e0), oe1 = __builtin_amdgcn_ds_bpermute((lane ^ 16) << 2, e1);
              const bool ofirst = ov0 > v0 || (ov0 == v0 && oe0 < e0);
              const float w0 = ofirst ? ov0 : v0; const int f0 = ofirst ? oe0 : e0;
              const float c1 = ofirst ? v0 : ov0; const int d1 = ofirst ? e0 : oe0;
              const float c2 = ofirst ? ov1 : v1; const int d2 = ofirst ? oe1 : e1;
              const bool s2 = c2 > c1 || (c2 == c1 && d2 < d1);
              v0 = w0; e0 = f0; v1 = s2 ? c2 : c1; e1 = s2 ? d2 : d1; }
            { unsigned char* x8 = ws + WS_XB8 + (size_t)m * D + 256 * fq; const float sc8 = 8.0f * inv;
#pragma unroll
              for (int s_ = 0; s_ < 32; s_ += 2) { const u32x4 w0 = __builtin_bit_cast(u32x4, a[s_]), w1 = __builtin_bit_cast(u32x4, a[s_ + 1]); u32x4 o8;
                  o8.x = pk4_fp8(sc8 * bf_lo(w0.x), sc8 * bf_hi(w0.x), sc8 * bf_lo(w0.y), sc8 * bf_hi(w0.y)); o8.y = pk4_fp8(sc8 * bf_lo(w0.z), sc8 * bf_hi(w0.z), sc8 * bf_lo(w0.w), sc8 * bf_hi(w0.w));
                  o8.z = pk4_fp8(sc8 * bf_lo(w1.x), sc8 * bf_hi(w1.x), sc8 * bf_lo(w1.y), sc8 * bf_hi(w1.y)); o8.w = pk4_fp8(sc8 * bf_lo(w1.z), sc8 * bf_hi(w1.z), sc8 * bf_lo(w1.w), sc8 * bf_hi(w1.w));
                  *(u32x4*)(x8 + 8 * s_) = o8; } }
            const float x1 = expf(v1 - v0), g0 = 1.0f / (1.0f + x1), g1 = x1 * g0;
            if (fq == 0) { u32x4 t; t.x = (unsigned)e0 | ((unsigned)e1 << 8); t.y = f2u(g0); t.z = f2u(g1); t.w = f2u(inv); TOK[m] = t; }
            int mine = 0;
#pragma unroll
            for (int e = 0; e < 8; ++e) { const int c = __popcll(__ballot(fq == 0 && e0 == e)) + __popcll(__ballot(fq == 0 && e1 == e)); mine = lane == e ? c : mine; }
            if (lane < 8) lcnt[I.wave * 8 + lane] = mine;
        }
        LDS_WAIT(); __syncthreads();
        if (I.tid < (packed ? 16 : 8)) { const int h_ = I.tid >> 3, e_ = I.tid & 7; LAS const int* lc = lcnt + h_ * 32 + e_; CNT[(grp0 + h_) * 8 + e_] = (lc[0] + lc[8]) + (lc[16] + lc[24]); }
        __syncthreads();
    }
}

__device__ __forceinline__ int isum(int v, int lane) {
#pragma unroll
    for (int o = 1; o < 64; o <<= 1) v += __builtin_amdgcn_ds_bpermute((lane ^ o) << 2, v);
    return v;
}
__device__ __forceinline__ void pos_phase(const Ptrs& P, int wave, const bool packed = false  ) {
    const Ids I = make_ids(wave); if (!packed && I.wave != 0) return;
    const int lane = I.lane; unsigned char* ws = kws();
    const u32x4* TOK = (const u32x4*)(ws + WS_TOK); const int* CNT = (const int*)(ws + WS_CNT); int* POS = (int*)(ws + WS_POS); int* ROWTOK = (int*)(ws + WS_ROWTOK); float* ROWINV = (float*)(ws + WS_ROWINV); int* TILES = (int*)(ws + WS_TILES);
    const int vcu = packed ? I.bx * NWAVES + I.wave : I.gw >> 3, vstep = packed ? M / 64 : I.G;
    for (int grp = vcu; grp < M / 64; grp += vstep) {
        int tot[8], pre[8];
#pragma unroll
        for (int e = 0; e < 8; ++e) { tot[e] = 0; pre[e] = 0; }
#pragma unroll
        for (int q = 0; q < 4; ++q) { const int r = lane + 64 * q; const int4 c0 = *(const int4*)(CNT + r * 8), c1 = *(const int4*)(CNT + r * 8 + 4); const int cc[8] = {c0.x, c0.y, c0.z, c0.w, c1.x, c1.y, c1.z, c1.w};
#pragma unroll
            for (int e = 0; e < 8; ++e) { tot[e] += cc[e]; pre[e] += r < grp ? cc[e] : 0; } }
        int off[8], run = 0;
#pragma unroll
        for (int e = 0; e < 8; ++e) { tot[e] = isum(tot[e], lane); pre[e] = isum(pre[e], lane); off[e] = run; run += tot[e]; }
        const int m = 64 * grp + lane; const u32x4 t = TOK[m]; const int e0 = t.x & 0xff, e1 = (t.x >> 8) & 0xff;
        const unsigned long long lt = (1ull << lane) - 1ull; int p0 = 0, p1 = 0; unsigned f0 = 0u, f1 = 0u;
        int pidx = 0;
#pragma unroll
        for (int e = 0; e < 8; ++e) pidx += tot[e] >> 8;
#pragma unroll
        for (int e = 0; e < 8; ++e) { const unsigned long long mk = __ballot(e0 == e || e1 == e); const int k = pre[e] + __popcll(mk & lt), r = off[e] + k;
            const int fullr = tot[e] & ~255; const bool hasp = (tot[e] & 255) != 0;
            const unsigned fl = (hasp && pidx >= 128 && k >= fullr) ? (0x80000000u | ((unsigned)((pidx - 128) * 256 + (k & 255)) << 16)) : 0u;
            p0 = e0 == e ? r : p0; p1 = e1 == e ? r : p1; f0 = e0 == e ? fl : f0; f1 = e1 == e ? fl : f1; pidx += hasp ? 1 : 0; }
        POS[2 * m] = (int)((unsigned)p0 | f0); POS[2 * m + 1] = (int)((unsigned)p1 | f1); ROWTOK[p0] = m; ROWTOK[p1] = m; const unsigned tw = t.w; ROWINV[p0] = u2f(tw); ROWINV[p1] = u2f(tw);
        if (grp == 0) {
#pragma unroll
            for (int q = 0; q < 4; ++q) ROWTOK[NASG + lane + 64 * q] = 0;
            if (lane == 0) { int nt = 0;
                for (int e = 0; e < 8; ++e) for (int k = 0; 256 * (k + 1) <= tot[e]; ++k) { *(int4*)(TILES + 4 * nt) = make_int4(e, off[e] + 256 * k, 256, 0); ++nt; }
                for (int e = 0; e < 8; ++e) if (tot[e] & 255) { *(int4*)(TILES + 4 * nt) = make_int4(e, off[e] + (tot[e] & ~255), tot[e] & 255, 0); ++nt; }
                TILES[255 * 4] = nt; }
        }
    }
}

__device__ __forceinline__ void final_phase(const Ptrs& P, int wave) {
    const Ids I = make_ids(wave); const int lane = I.lane; unsigned char* ws = kws();
    const u32x4* TOK = (const u32x4*)(ws + WS_TOK); const int* POS = (const int*)(ws + WS_POS); const bf16* Y = (const bf16*)(ws + WS_Y);
    const f32x4* gf = (const f32x4*)kin(24) + lane; f32x4 gv[4];
#pragma unroll
    for (int j = 0; j < 4; ++j) gv[j] = gf[64 * j];
    const bool poison = xb_ld((unsigned*)(ws + WS_CTL) + CW_BAR + XB_TMO) != 0u;
    for (int m = I.gw; m < M; m += I.NGW) { f32x4* xr = (f32x4*)(kout() + (size_t)m * D) + lane; const u32x2* hr = (const u32x2*)((const bf16*)(ws + WS_XB) + (size_t)m * D) + lane; f32x4 v[4]; float ss = 0.f;
        const u32x4 t = TOK[m]; const unsigned ty = t.y, tz = t.z; const float g0 = u2f(ty), g1 = u2f(tz); const unsigned q0 = (unsigned)__builtin_amdgcn_readfirstlane(POS[2 * m]), q1 = (unsigned)__builtin_amdgcn_readfirstlane(POS[2 * m + 1]);
        const bool s0 = (q0 >> 31) != 0u, s1 = (q1 >> 31) != 0u; const int p0 = s0 ? NASG + (int)((q0 >> 16) & 0x7fffu) : (int)(q0 & 0xffffu), p1 = s1 ? NASG + (int)((q1 >> 16) & 0x7fffu) : (int)(q1 & 0xffffu);
        const u32x2* y0 = (const u32x2*)(Y + (size_t)p0 * D) + lane; const u32x2* y1 = (const u32x2*)(Y + (size_t)p1 * D) + lane;
        u32x2 hw[4], ya_[4], yb_[4];
#pragma unroll
        for (int j = 0; j < 4; ++j) { hw[j] = hr[64 * j]; ya_[j] = y0[64 * j]; yb_[j] = y1[64 * j]; }
        f32x4 ya[4], yb[4];
#pragma unroll
        for (int j = 0; j < 4; ++j) { ya[j] = (f32x4){bf_lo(ya_[j].x), bf_hi(ya_[j].x), bf_lo(ya_[j].y), bf_hi(ya_[j].y)}; yb[j] = (f32x4){bf_lo(yb_[j].x), bf_hi(yb_[j].x), bf_lo(yb_[j].y), bf_hi(yb_[j].y)}; }
        if (s0 || s1) {
#pragma unroll
            for (int sl = 1; sl < 4; ++sl)
#pragma unroll
                for (int j = 0; j < 4; ++j) {
                    if (s0) { const u32x2 c = y0[64 * j + sl * (2048 * D / 4)]; ya[j] += (f32x4){bf_lo(c.x), bf_hi(c.x), bf_lo(c.y), bf_hi(c.y)}; }
                    if (s1) { const u32x2 c = y1[64 * j + sl * (2048 * D / 4)]; yb[j] += (f32x4){bf_lo(c.x), bf_hi(c.x), bf_lo(c.y), bf_hi(c.y)}; } } }
#pragma unroll
        for (int j = 0; j < 4; ++j) { v[j] = (f32x4){bf_lo(hw[j].x), bf_hi(hw[j].x), bf_lo(hw[j].y), bf_hi(hw[j].y)};
            v[j][0] += g0 * ya[j][0] + g1 * yb[j][0]; v[j][1] += g0 * ya[j][1] + g1 * yb[j][1]; v[j][2] += g0 * ya[j][2] + g1 * yb[j][2]; v[j][3] += g0 * ya[j][3] + g1 * yb[j][3];
            ss += (v[j][0] * v[j][0] + v[j][1] * v[j][1]) + (v[j][2] * v[j][2] + v[j][3] * v[j][3]); }
        ss = wave_sum(ss, lane); float inv = 1.0f / sqrtf(ss * (1.0f / D) + RMS_EPS); if (poison) inv = __builtin_nanf("");
#pragma unroll
        for (int j = 0; j < 4; ++j) xr[64 * j] = v[j] * inv * gv[j]; }
}

__global__ void __launch_bounds__(NWAVES * 64, 2) trunk_fwd(Ptrs P) {
    extern __shared__ __attribute__((aligned(16))) unsigned char lds_raw[];
    LAS unsigned char* lds = (LAS unsigned char*)lds_raw;
    volatile LAS unsigned* MISC = (volatile LAS unsigned*)(lds + MISC_OFF);
#define OPQ_GB int G = gridDim.x, bx = blockIdx.x; asm volatile("" : "+s"(G), "+s"(bx))
    const int wave0 = __builtin_amdgcn_readfirstlane((int)threadIdx.x >> 6);
    for (int u = threadIdx.x; u < (LDS_BYTES - LDSCTL_OFF) / 4; u += NWAVES * 64) ((LAS unsigned*)(lds + LDSCTL_OFF))[u] = 0u;
    __syncthreads();
    XcdBarrier bar = xcd_barrier_post((unsigned*)(kws() + WS_CTL) + CW_BAR, MISC + 8);
#define GRID_BAR() do { XcdBarrier b_ = bar; asm volatile("" : "+s"(b_.x)); xcd_barrier(b_, wave0 == 0 && hw_lane() == 0); } while (0)

    p0_prologue(P, lds, wave0);
    GRID_BAR();

    for (int l = 0; l < 2; ++l) {
        { unsigned char* ws = kws(); OPQ_GB; pg8::Sched2D S; S.init(ws + WS_XB, (bf16*)(ws + WS_WIN) + (size_t)l * D * D, D * 2, D * 2, M, D, G, bx);
          EpiInProj E{(const float*)(ws + WS_STATS), (bf16*)(ws + WS_UZ), (bf16*)(ws + WS_V)}; pg8::gemm_phase(lds, pg8::GemmP{D * 2, D * 2, D / 64}, S, E, wave0); }
        GRID_BAR();
        { unsigned char* ws = kws(); OPQ_GB;
          if (G == 256 && (bx >> 3) >= 16) {
              const int fr = (bx & 7) * 16 + ((bx >> 3) - 16); pool_filter(wave0, fr, 128);
              if (l == 0) { pro_convert(lds, wave0, fr, 128, 128, PRO_SPLIT); moe_convert_wg(lds, wave0, fr, 128, MOE_TILES, MOE_TILES + 88); }
              moe_convert_wg(lds, wave0, fr, 128, l == 0 ? 0 : MF_C, l == 0 ? MF_A : MF_D);
          } else {
              for (int i = 0;; ++i) { const int un = pg8::head_unit_of(i, G, bx); if (un < 0) break;
                  { pg8::SchedHead S{(const char*)(ws + WS_UZ), (const char*)((bf16*)(ws + WS_WE) + (size_t)l * NH * 256 * 256), (size_t)NR * UZK * 2, (size_t)256 * 256 * 2, UZK * 2, un};
                    EpiE E{(float*)(ws + WS_E)}; pg8::gemm_phase(lds, pg8::GemmP{UZK * 2, 256 * 2, 4}, S, E, wave0); }
                  wg_publish_local(wave0 == 0 && hw_lane() == 0, false);
                  scan_unit(l, un, lds, wave0);
                  wg_publish_local(wave0 == 0 && hw_lane() == 0, true);
                  { pg8::SchedHead S{(const char*)(ws + WS_UZ), (const char*)((bf16*)(ws + WS_TW) + (size_t)l * NH * 256 * UZK), (size_t)NR * UZK * 2, (size_t)256 * UZK * 2, UZK * 2, un};
                    EpiY E{(bf16*)(ws + WS_H)}; pg8::gemm_phase(lds, pg8::GemmP{UZK * 2, UZK * 2, UZK / 64}, S, E, wave0); } }
              if (G == 256 && l == 0) pro_convert(lds, wave0, (bx & 7) * 16 + (bx >> 3), 128, PRO_SPLIT, 896 + 2 * 704);
              if (G != 256) { pool_filter(wave0, bx, G); if (l == 0) { pro_convert(lds, wave0, bx, G); moe_convert_wg(lds, wave0, bx, G, MOE_TILES, MOE_TILES + 88); } moe_convert_wg(lds, wave0, bx, G, l == 0 ? 0 : MF_C, l == 0 ? MF_A : MF_D); } } }
        GRID_BAR();
        { unsigned char* ws = kws(); OPQ_GB; pg8::Sched2D S; S.init(ws + WS_H, (bf16*)(ws + WS_WGLU) + (size_t)l * 512 * 512, DSSM * 2, DSSM * 2, M, DSSM, G, bx);
          EpiGlu E{(const bf16*)(ws + WS_H), kin(12) + l * DSSM, (bf16*)(ws + WS_MIXED)}; pg8::gemm_phase(lds, pg8::GemmP{DSSM * 2, DSSM * 2, DSSM / 64}, S, E, wave0);
          { const bool part = G > 128; if (!part || bx >= 128) { const int fr = part ? bx - 128 : bx, nf = part ? G - 128 : G;
              if (l == 0) misc_fill(P, lds, wave0, fr, nf);
              moe_convert_wg(lds, wave0, fr, nf, l == 0 ? MF_A : MF_D, l == 0 ? MF_B : (G == 256 ? MT_END - MT_POS - MT_RT : MT_END)); }
            else if (l == 0 && G == 256) { if (wave0 == 0) pool_fold_item_rolled(P, 896 + bx, (LAS float*)lds, hw_lane()); } } }
        GRID_BAR();
        { unsigned char* ws = kws(); OPQ_GB; pg8::Sched2D S; S.init(ws + WS_MIXED, (bf16*)(ws + WS_WOUT) + (size_t)l * D * D, D * 2, D * 2, M, D, G, bx);
          EpiRes E{nullptr, (bf16*)(ws + WS_XB), (float*)(ws + WS_STATS), nullptr};     pg8::gemm_phase(lds, pg8::GemmP{D * 2, D * 2, D / 64}, S, E, wave0); }
        GRID_BAR();
        if (l == 0) {
            { unsigned char* ws = kws(); OPQ_GB; pg8::Sched2D S; S.init(ws + WS_XB, ws + WS_WGU, D * 2, D * 2, M, 2 * DFF, G, bx);
              EpiUp E{(const float*)(ws + WS_STATS), ws + WS_HID}; pg8::gemm_phase(lds, pg8::GemmP{D * 2, D * 2, D / 64}, S, E, wave0);
              { constexpr int NU = (M / 256) * (2 * DFF / 256); const int rem = NU % G;
                if (rem != 0) { if (bx >= rem) moe_convert_wg(lds, wave0, bx - rem, G - rem, MF_B, MF_C); } else moe_convert_wg(lds, wave0, bx, G, MF_B, MF_C); } }
            GRID_BAR();
            { unsigned char* ws = kws(); OPQ_GB; pg8::Sched2D S; S.init(ws + WS_HID, ws + WS_WD, DFF, DFF, M, D, G, bx);
              EpiRes E{nullptr, (bf16*)(ws + WS_XB), (float*)(ws + WS_STATS), nullptr}; pg8::gemm_phase<EpiRes, pg8::Sched2D, true>(lds, pg8::GemmP{DFF, DFF, DFF / 128}, S, E, wave0); }
            GRID_BAR();
        }
    }
    { OPQ_GB; if (G == 256) { if (bx < 128) routing_phase(P, lds, wave0, true); else moe_convert_wg(lds, wave0, bx - 128, 128, MT_END - MT_POS - MT_RT, MT_END - MT_POS); } else routing_phase(P, lds, wave0); }
    GRID_BAR();
    { OPQ_GB; if (G == 256) { if (bx < 32) pos_phase(P, wave0, true); else moe_convert_wg(lds, wave0, bx - 32, 224, MT_END - MT_POS, MT_END); } else pos_phase(P, wave0); }
    GRID_BAR();
    { unsigned char* ws = kws(); OPQ_GB; pg8::SchedMoe<true> S; S.init(lds, wave0 * 64 + hw_lane(), ws + WS_XB8, ws + WS_MWGU, (size_t)2 * DFF * D, D, D, 2 * DFF, G, bx);
      EpiUpMoe E{ws + WS_HIDM}; pg8::gemm_phase<EpiUpMoe, pg8::SchedMoe<true>, true>(lds, pg8::GemmP{D, D, D / 128}, S, E, wave0);
      { const int rem = S.nwg % G, nidle = G - rem;
        if (rem != 0 && 2 * nidle >= G) { if (bx >= rem) moe_convert_wg(lds, wave0, bx - rem, nidle, MT_END, MOE_TILES); } else moe_convert_wg(lds, wave0, bx, G, MT_END, MOE_TILES); } }
    GRID_BAR();
    { unsigned char* ws = kws(); OPQ_GB; pg8::SchedMoe<false> S; S.init(lds, wave0 * 64 + hw_lane(), ws + WS_HIDM, ws + WS_MWD, (size_t)D * DFF, DFF, DFF, D, G, bx);
      EpiDownMoe E{(bf16*)(ws + WS_Y)}; pg8::gemm_phase<EpiDownMoe, pg8::SchedMoe<false>, true>(lds, pg8::GemmP{DFF, DFF, DFF / 128}, S, E, wave0); }
    GRID_BAR();
    final_phase(P, wave0);
}

extern "C" void kernel_launch(void* const* d_in, const int* in_sizes, int n_in, void* d_out, int out_size, void* d_ws, size_t ws_size, hipStream_t stream) {
    static int grid = 0;
    if (grid == 0) {
        if (n_in != 25 || in_sizes[0] != M * D || out_size != M * D || ws_size < WS_END) { fprintf(stderr, "kernel_launch: unexpected shapes / workspace (n_in %d, ws %zu)\n", n_in, ws_size); grid = -1; return; }
        int dev = 0, cus = 0, per_cu = 0;
        if (hipGetDevice(&dev) != hipSuccess || hipDeviceGetAttribute(&cus, hipDeviceAttributeMultiprocessorCount, dev) != hipSuccess) { grid = -1; return; }
        if (hipFuncSetAttribute((const void*)trunk_fwd, hipFuncAttributeMaxDynamicSharedMemorySize, LDS_BYTES) != hipSuccess) { grid = -1; return; }
        if (hipOccupancyMaxActiveBlocksPerMultiprocessor(&per_cu, (const void*)trunk_fwd, NWAVES * 64, LDS_BYTES) != hipSuccess || per_cu < 1) { fprintf(stderr, "kernel_launch: occupancy query says %d\n", per_cu); }
        (void)hipGetLastError();
        grid = cus;
    }
    if (grid < 0) return;
    (void)hipMemsetAsync((char*)d_ws + WS_CTL, 0, CTL_ZERO_BYTES, stream);
    Ptrs p{};
    for (int i = 0; i < 25; ++i) p.in[i] = (const float*)d_in[i];
    p.out = (float*)d_out; p.ws = (unsigned char*)d_ws;
    hipLaunchKernelGGL(trunk_fwd, dim3(grid), dim3(NWAVES * 64), LDS_BYTES, stream, p);
}
```

```cpp
#include <hip/hip_runtime.h>
#include <cstdio>
#include <cstdint>

#define LAS __attribute__((address_space(3)))
#define GAS __attribute__((address_space(1)))
typedef unsigned short bf16;
typedef short bf16x8 __attribute__((ext_vector_type(8)));
typedef float f32x4 __attribute__((ext_vector_type(4)));
typedef float f32x2 __attribute__((ext_vector_type(2)));
typedef double f64x2_ __attribute__((ext_vector_type(2)));
typedef unsigned u32x4 __attribute__((ext_vector_type(4)));
typedef unsigned u32x2 __attribute__((ext_vector_type(2)));

constexpr int BATCH = 8, SEQ = 2048, D = 1024, M = BATCH * SEQ;
constexpr int DSSM = 512, NH = 32, SG = 16, SP = 64, TC = 16  , NR = M / TC  , UZK = TC * SG + 2 * SP  ;
constexpr int DPOOL = 512, DFF = 2816, NE = 8;
constexpr float RMS_EPS = 1e-6f;
constexpr int NWAVES = 8;

constexpr size_t MiB = 1u << 20;
constexpr size_t WS_CTL = 0, CTL_ZERO_BYTES = 16384;
constexpr size_t WS_STATS = 1 * MiB;
constexpr size_t WS_TOK = 2 * MiB;
constexpr size_t WS_CNT = WS_TOK + 256 * 1024;
constexpr size_t WS_POS = WS_CNT + 16 * 1024;
constexpr size_t WS_ROWTOK = WS_POS + 128 * 1024;
constexpr size_t WS_ROWINV = WS_ROWTOK + 192 * 1024;
constexpr size_t WS_TILES = WS_ROWINV + 192 * 1024;
constexpr size_t WS_LAMT = 3 * MiB;
constexpr size_t WS_MWGU = 4 * MiB;
constexpr size_t WS_MWD = 92 * MiB;
constexpr size_t WS_XB = 136 * MiB;
constexpr size_t WS_MIXED = 168 * MiB;
constexpr size_t WS_WIN = 200 * MiB;
constexpr size_t WS_WGLU = 204 * MiB;
constexpr size_t WS_WOUT = 205 * MiB;
constexpr size_t WS_TW = 209 * MiB;
constexpr size_t WS_WE = 221 * MiB;
constexpr size_t WS_WGU = 229 * MiB;
constexpr size_t WS_WD = 240 * MiB;
constexpr size_t WS_UZ = 246 * MiB;
constexpr size_t WS_E = 270 * MiB;
constexpr size_t WS_V = 286 * MiB;
constexpr size_t WS_H = 302 * MiB;
constexpr size_t WS_HID = 246 * MiB;
constexpr size_t WS_HIDM = 168 * MiB;
constexpr size_t WS_XB8 = 72 * MiB;
constexpr size_t WS_Y = WS_MWGU;
constexpr int NASG = 2 * M;
constexpr size_t WS_END = 346 * MiB;
static_assert(WS_HIDM + (size_t)(NASG + 256) * DFF * 2 <= WS_END && (size_t)(NASG + 4 * 8 * 256) * D * 2 <= WS_MWD - WS_MWGU && WS_TILES + 4096 <= 3 * MiB, "d_ws map");
constexpr int CW_BAR = 0;

constexpr int RING_BYTES = 131072, LDSCTL_OFF = RING_BYTES, MISC_OFF = LDSCTL_OFF + 320, LDS_BYTES = 147456;

#define LDS_WAIT() asm volatile("s_waitcnt lgkmcnt(0)" ::: "memory")
#define VM_WAIT() asm volatile("s_waitcnt vmcnt(0)" ::: "memory")

__device__ __forceinline__ unsigned f2bf(float f) { unsigned u = __builtin_bit_cast(unsigned, f); return (u + 0x7fffu + ((u >> 16) & 1u)) >> 16; }
typedef __bf16 bf16x2_t __attribute__((ext_vector_type(2)));
__device__ __forceinline__ unsigned pk2(float lo, float hi) { const f32x2 v = {lo, hi}; return __builtin_bit_cast(unsigned, __builtin_convertvector(v, bf16x2_t)); }
__device__ __forceinline__ float u2f(unsigned u) { return __builtin_bit_cast(float, u); }
__device__ __forceinline__ unsigned f2u(float f) { return __builtin_bit_cast(unsigned, f); }
__device__ __forceinline__ unsigned pk4_fp8(float a, float b, float c, float d) {
    a = __builtin_amdgcn_fmed3f(a, -448.f, 448.f); b = __builtin_amdgcn_fmed3f(b, -448.f, 448.f); c = __builtin_amdgcn_fmed3f(c, -448.f, 448.f); d = __builtin_amdgcn_fmed3f(d, -448.f, 448.f);
    int p = __builtin_amdgcn_cvt_pk_fp8_f32(a, b, 0, false); p = __builtin_amdgcn_cvt_pk_fp8_f32(c, d, p, true); return (unsigned)p; }
__device__ __forceinline__ float bf_lo(unsigned w) { return __builtin_bit_cast(float, w << 16); }
__device__ __forceinline__ float bf_hi(unsigned w) { return __builtin_bit_cast(float, w & 0xffff0000u); }
__device__ __forceinline__ float fast_sigmoid(float v) { return __builtin_amdgcn_rcpf(1.0f + __expf(-v)); }
__device__ __forceinline__ float gelu_tanh(float x) { const float w = __builtin_fmaf(x * x, -0.10294324f, -2.3022082f);
    return x * __builtin_amdgcn_rcpf(1.0f + __builtin_amdgcn_exp2f(x * w)); }
__device__ __forceinline__ float shx(float v, int lane, int mask) { return __builtin_bit_cast(float, __builtin_amdgcn_ds_bpermute((lane ^ mask) << 2, __builtin_bit_cast(int, v))); }
__device__ __forceinline__ float wave_sum(float v, int lane) {
#pragma unroll
    for (int o = 1; o < 64; o <<= 1) v += shx(v, lane, o);
    return v;
}

namespace pg8 {
constexpr int BM = 256, BK = 64, HALF = 128, HTB = HALF * BK * 2, STAGE_BYTES = 8 * HTB, NXCD = 8, WGM = 8;
__host__ __device__ __forceinline__ int lds_byte(int r, int c) { const int st = (r >> 4) * 2 + (c >> 5), rr = r & 15, cc = c & 31, ob = rr * 64 + cc * 2; return st * 1024 + (ob ^ (((ob >> 9) & 1) << 5)); }
__host__ __device__ __forceinline__ void stage_rc(int b, int& R, int& C) { const int st = b / 1024, sb = b % 1024, swz = sb ^ (((sb >> 9) & 1) << 5); R = (st >> 1) * 16 + swz / 64; C = (st & 1) * 32 + (swz % 64) / 2; }
__host__ __device__ __forceinline__ int perm32(int rho) { const int n = rho >> 4, i = rho & 15; return 8 * (i >> 2) + 4 * n + (i & 3); }

struct Unit { const char* a; const char* b; const int* rows; int pm, pn, x, valid, nt; };
struct GemmP { int ldaB, ldbB, nt; };

struct Sched2D {
    static constexpr bool GATHER = false, VARNT = false;
    const char* A; const char* B; int ldaB, ldbB, nM, nN, nwg, G, c;
    __device__ __forceinline__ void init(const void* A_, const void* B_, int ldaB_, int ldbB_, int Mr, int Nc, int G_, int c_) { A = (const char*)A_; B = (const char*)B_; ldaB = ldaB_; ldbB = ldbB_; nM = Mr / BM; nN = Nc / BM; nwg = nM * nN; G = G_; c = c_; }
    __device__ __forceinline__ bool next(int i, Unit& u) const {
        const long L = (long)i * G + c; if (L >= nwg) return false;
        int wgid = (int)L; { const int q = nwg / NXCD, r = nwg % NXCD, xcd = wgid % NXCD, off = wgid / NXCD; wgid = (xcd < r ? xcd * (q + 1) : r * (q + 1) + (xcd - r) * q) + off; }
        const int nig = WGM * nN, gid = wgid / nig, fm = gid * WGM, gsz = (nM - fm) < WGM ? (nM - fm) : WGM;
        u.pm = fm + ((wgid % nig) % gsz); u.pn = (wgid % nig) / gsz; u.x = 0; u.valid = BM; u.rows = nullptr;
        u.a = A + (size_t)u.pm * BM * ldaB; u.b = B + (size_t)u.pn * BM * ldbB; return true;
    }
};
struct SchedHead {
    static constexpr bool GATHER = false, VARNT = false;
    const char* A; const char* B; size_t aStride, bStride; int ldaB, un;
    __device__ __forceinline__ bool next(int i, Unit& u) const {
        if (i > 0 || un < 0) return false;
        const int head = un >> 2, pm = un & 3;
        u.pm = pm; u.pn = 0; u.x = head; u.valid = BM; u.rows = nullptr; u.a = A + (size_t)head * aStride + (size_t)pm * BM * ldaB; u.b = B + (size_t)head * bStride; return true;
    }
};
__device__ __forceinline__ int head_unit_of(int i, int G, int c) { if (G == 256) { const int x = c & 7, idx = c >> 3; return (i == 0 && idx < 16) ? x * 16 + idx : -1; } const int un = i * G + c; return un < 128 ? un : -1; }

__device__ __forceinline__ unsigned char* kws_();
constexpr size_t WS_TILES_ = WS_TILES, WS_ROWTOK_ = WS_ROWTOK; constexpr int NASG_ = 2 * M;
constexpr int TILE_LDS_OFF = 131072 + 1024;
constexpr int SC_LDS_OFF = TILE_LDS_OFF + 4096 + 8192;
constexpr int IX_LDS_OFF = TILE_LDS_OFF + 4096;
template <bool GA> struct SchedMoe {
    static constexpr bool GATHER = GA, VARNT = !GA;
    static constexpr int KSPLIT = 4, KSL = 6;
    const char* A; const char* B; size_t bStrideE; LAS const int* tl; int ldaB, ldbB, nM, nN, nwg, G, c, nsub, ntFull;
    __device__ __forceinline__ void init(LAS unsigned char* lds, int tid, const void* A_, const void* B_, size_t bStrideE_, int ldaB_, int ldbB_, int Nc, int G_, int c_) {
        A = (const char*)A_; B = (const char*)B_; bStrideE = bStrideE_; ldaB = ldaB_; ldbB = ldbB_;
        LAS int* t = (LAS int*)(lds + TILE_LDS_OFF); const int* g = (const int*)(kws_() + WS_TILES_);
        for (int i = tid; i < 1024; i += 512) t[i] = g[i];
        asm volatile("s_waitcnt vmcnt(0) lgkmcnt(0)" ::: "memory"); __syncthreads();
        tl = t; nM = __builtin_amdgcn_readfirstlane(t[255 * 4]); nN = Nc / BM; G = G_; c = c_; nsub = 0; ntFull = ldaB_ / 128;
        if constexpr (!GA) { constexpr int nMain = 128;        if (nM > nMain) { nsub = __builtin_amdgcn_readfirstlane((nM - nMain) * nN * KSPLIT); nM = nMain; } }
        nwg = __builtin_amdgcn_readfirstlane(nM * nN); }
    __device__ __forceinline__ bool next(int i, Unit& u) const {
        const int L = i * G + c; size_t ko = 0; u.nt = ntFull;
        if (L >= nwg) { if (GA || L - nwg >= nsub) return false;
            const int j = L - nwg, sl = j & (KSPLIT - 1), o = j / (KSPLIT * nN); u.pn = (j / KSPLIT) % nN; u.pm = nM + o;
            u.x = NASG_ + (sl * 8 + o) * BM; ko = (size_t)(sl * KSL * 128); u.nt = sl < KSPLIT - 1 ? KSL : ntFull - (KSPLIT - 1) * KSL;
        } else {
            int wgid = L; { const int q = nwg / NXCD, r = nwg % NXCD, xcd = wgid % NXCD, off = wgid / NXCD; wgid = (xcd < r ? xcd * (q + 1) : r * (q + 1) + (xcd - r) * q) + off; }
            const int nig = WGM * nN, gid = wgid / nig, fm = gid * WGM, gsz = (nM - fm) < WGM ? (nM - fm) : WGM;
            u.pm = fm + ((wgid % nig) % gsz); u.pn = (wgid % nig) / gsz; u.x = -1; }
        const int e = __builtin_amdgcn_readfirstlane(tl[u.pm * 4]), row0 = __builtin_amdgcn_readfirstlane(tl[u.pm * 4 + 1]); u.valid = __builtin_amdgcn_readfirstlane(tl[u.pm * 4 + 2]); if (u.x < 0) u.x = row0;
        u.rows = (const int*)(kws_() + WS_ROWTOK_) + row0; u.a = GA ? A : A + (size_t)row0 * ldaB + ko; u.b = B + (size_t)e * bStrideE + (size_t)u.pn * BM * ldbB + ko; return true;
    }
};

typedef int i32x4 __attribute__((ext_vector_type(4)));
typedef int i32x8 __attribute__((ext_vector_type(8)));
template <int SX, int SY> __device__ __forceinline__ f32x4 mfma8_t(bf16x8 x0, bf16x8 x1, bf16x8 y0, bf16x8 y1, f32x4 c) {
    const i32x8 x = __builtin_shufflevector(__builtin_bit_cast(i32x4, x0), __builtin_bit_cast(i32x4, x1), 0, 1, 2, 3, 4, 5, 6, 7), y = __builtin_shufflevector(__builtin_bit_cast(i32x4, y0), __builtin_bit_cast(i32x4, y1), 0, 1, 2, 3, 4, 5, 6, 7);
    return __builtin_amdgcn_mfma_scale_f32_16x16x128_f8f6f4(x, y, c, 0, 0, 0, SX, 0, SY);
}
#define mfma8(x0, x1, y0, y1, c, sx, sy) mfma8_t<sx, sy>(x0, x1, y0, y1, c)
template <class Epi, class Sched, bool F8 = false, int MODE = 0>
__device__ __forceinline__ void gemm_phase(LAS unsigned char* lds, const GemmP g, const Sched& S, const Epi& E, int wid) {
    int lane; asm volatile("v_mbcnt_lo_u32_b32 %0, -1, 0\n\tv_mbcnt_hi_u32_b32 %0, -1, %0" : "=v"(lane));
    asm volatile("" : "+s"(wid));
    const int tid = wid * 64 + lane, wr = wid >> 2, wc = wid & 3, fr = lane & 15, fq = lane >> 4;
    constexpr bool GA = Sched::GATHER;
    unsigned vAc[2][2], vAn[2][2], voffB[2];
#pragma unroll
    for (int i = 0; i < 2; ++i) { int R, C; stage_rc(tid * 16 + i * 8192, R, C); const int Rb = Epi::PERM ? ((R & ~31) + perm32(R & 31)) : R;
        voffB[i] = (unsigned)(Rb * g.ldbB + C * 2); }
    const size_t kstep = (size_t)(BK * 2);
    const size_t hB = (size_t)HALF * g.ldbB;
    const unsigned ldsw = (unsigned)wid * 1024u;
    const int aoff = lds_byte(wr * 64 + fr, fq * 8), boff = lds_byte(wc * 32 + fr, fq * 8);
    constexpr int KOFF = 1024;
#define PG8_SA(b, h) (((b) * 2 + (h)) * HTB)
#define PG8_SB(b, h) ((4 + (b) * 2 + (h)) * HTB)
#define PG8_STAGE(bufoff, gbase, voff) do { _Pragma("unroll") for (int _i = 0; _i < 2; ++_i) { unsigned vo_ = (voff)[_i]; asm volatile("" : "+v"(vo_));     \
        __builtin_amdgcn_global_load_lds((const unsigned*)((const char*)(gbase) + vo_), (LAS unsigned*)(lds + (bufoff) + ldsw + _i * 8192), 16, 0, 0); } } while (0)
#define PG8_LDA(dst, b, h) do { _Pragma("unroll") for (int m = 0; m < 4; ++m) _Pragma("unroll") for (int k = 0; k < 2; ++k) dst[m][k] = *(const LAS bf16x8*)(lds + PG8_SA(b, h) + aoff + m * 2048 + k * KOFF); } while (0)
#define PG8_LDB(dst, b, h) do { _Pragma("unroll") for (int n = 0; n < 2; ++n) _Pragma("unroll") for (int k = 0; k < 2; ++k) dst[n][k] = *(const LAS bf16x8*)(lds + PG8_SB(b, h) + boff + n * 2048 + k * KOFF); } while (0)
#define PG8_MMA(ai, bj, At, Bt) do { __builtin_amdgcn_s_setprio(1); _Pragma("unroll") for (int m = 0; m < 4; ++m) _Pragma("unroll") for (int n = 0; n < 2; ++n) { \
        if constexpr (F8) acc[ai][bj][m][n] = mfma8(Bt[n][0], Bt[n][1], At[m][0], At[m][1], acc[ai][bj][m][n], Epi::SCALE_B, Epi::SCALE_A); \
        else { _Pragma("unroll") for (int k = 0; k < 2; ++k) acc[ai][bj][m][n] = __builtin_amdgcn_mfma_f32_16x16x32_bf16(Bt[n][k], At[m][k], acc[ai][bj][m][n], 0, 0, 0); } } __builtin_amdgcn_s_setprio(0); } while (0)
#define PG8_MMA0(ai, bj, At, Bt) do { __builtin_amdgcn_s_setprio(1); _Pragma("unroll") for (int m = 0; m < 4; ++m) _Pragma("unroll") for (int n = 0; n < 2; ++n) { \
        if constexpr (F8) acc[ai][bj][m][n] = mfma8(Bt[n][0], Bt[n][1], At[m][0], At[m][1], zero4_, Epi::SCALE_B, Epi::SCALE_A); \
        else { acc[ai][bj][m][n] = __builtin_amdgcn_mfma_f32_16x16x32_bf16(Bt[n][0], At[m][0], zero4_, 0, 0, 0); acc[ai][bj][m][n] = __builtin_amdgcn_mfma_f32_16x16x32_bf16(Bt[n][1], At[m][1], acc[ai][bj][m][n], 0, 0, 0); } } __builtin_amdgcn_s_setprio(0); } while (0)
#define PG8_WAIT_V(n) asm volatile("s_waitcnt vmcnt(" #n ")" ::: "memory")
#define PG8_WAIT_L(n) asm volatile("s_waitcnt lgkmcnt(" #n ")" ::: "memory")
#define PG8_BAR __builtin_amdgcn_s_barrier()
#define PG8_SCHED __builtin_amdgcn_sched_barrier(0)
    Unit cur, nxt; int ui = 0;
    if (!S.next(0, cur)) return;
    f32x4 acc[2][2][4][2]; const f32x4 zero4_ = {0.f, 0.f, 0.f, 0.f};
    if constexpr (Epi::PEEL != 2) {
#pragma unroll
    for (int a = Epi::PEEL; a < 2; ++a)
#pragma unroll
        for (int b = 0; b < 2; ++b)
#pragma unroll
            for (int m = 0; m < 4; ++m)
#pragma unroll
                for (int n = 0; n < 2; ++n) { double d0_, d1_; asm volatile("v_mov_b64 %0, 0\n\tv_mov_b64 %1, 0" : "=v"(d0_), "=v"(d1_)); acc[a][b][m][n] = __builtin_bit_cast(f32x4, (f64x2_){d0_, d1_}); } }
    bf16x8 At[4][2], B0[2][2], B1[2][2];
    const char* cA = cur.a; const char* cB = cur.b;
    const size_t hA = GA ? (size_t)0 : (size_t)HALF * g.ldaB;
#pragma unroll
    for (int i = 0; i < 2; ++i) { int R, C; stage_rc(tid * 16 + i * 8192, R, C);
#pragma unroll
        for (int h = 0; h < 2; ++h) { const int rr = GA ? cur.rows[h * HALF + R] : R; vAc[h][i] = (unsigned)(rr * g.ldaB + C * 2); vAn[h][i] = vAc[h][i]; } }
#define PG8_STAGE_A(bufoff, gbase, h) PG8_STAGE(bufoff, (gbase) + (h) * hA, vAc[GA ? (h) : 0])
    if constexpr (GA) { Unit t1; if (S.next(1, t1)) { LAS unsigned* ix = (LAS unsigned*)(lds + IX_LDS_OFF) + tid * 4;
#pragma unroll
            for (int i = 0; i < 2; ++i) { int R, C; stage_rc(tid * 16 + i * 8192, R, C);
#pragma unroll
                for (int h = 0; h < 2; ++h) ix[h * 2 + i] = (unsigned)(t1.rows[h * HALF + R] * g.ldaB + C * 2); } } }
    float sc0_ = 0.f; if constexpr (Epi::SC) { if (wid < 4) sc0_ = E.scale_of(cur, tid); }
    if constexpr (MODE != 2) { PG8_STAGE(PG8_SB(0, 0), cB, voffB); PG8_STAGE(PG8_SB(0, 1), cB + hB, voffB); PG8_STAGE_A(PG8_SA(0, 0), cA, 0); PG8_STAGE_A(PG8_SA(0, 1), cA, 1); }
    if constexpr (MODE == 1) return;
    if (wr == 1) PG8_BAR;
    PG8_WAIT_V(2); PG8_BAR;
    PG8_STAGE(PG8_SB(1, 0), cB + kstep, voffB); PG8_STAGE_A(PG8_SA(1, 0), cA + kstep, 0); PG8_STAGE(PG8_SB(1, 1), cB + hB + kstep, voffB);
    PG8_WAIT_V(6); PG8_BAR;
    if constexpr (Epi::SC) { if (wid < 4) ((LAS float*)(lds + SC_LDS_OFF))[tid] = sc0_; }
    for (;;) {
        const bool has_next = S.next(ui + 1, nxt);
        const char* nA = has_next ? nxt.a : cA; const char* nB = has_next ? nxt.b : cB;
        int nt = Sched::VARNT ? cur.nt : g.nt; asm volatile("" : "+s"(nt));
#define PG8_TRIPBODY(MA, MB) { const bool last = (t == nt - 2); \
            const char* a1 = cA + (size_t)(t + 1) * kstep; \
            const char* a2 = last ? nA : cA + (size_t)(t + 2) * kstep; const char* b2 = last ? nB : cB + (size_t)(t + 2) * kstep; \
            const char* a3 = a2 + kstep; const char* b3 = b2 + kstep; \
            PG8_LDB(B0, 0, 0); PG8_LDB(B1, 0, 1); PG8_SCHED; PG8_LDA(At, 0, 0); PG8_STAGE_A(PG8_SA(1, 1), a1, 1); \
            if constexpr (GA) { if (last) {               \
                if (has_next) { int l3_; asm volatile("v_mbcnt_lo_u32_b32 %0, -1, 0\n\tv_mbcnt_hi_u32_b32 %0, -1, %0" : "=v"(l3_)); const u32x4 o4 = *((const LAS u32x4*)(lds + IX_LDS_OFF) + (wid * 64 + l3_)); \
                    vAc[0][0] = o4.x; vAc[0][1] = o4.y; vAc[1][0] = o4.z; vAc[1][1] = o4.w; } } } \
            PG8_WAIT_V(8); PG8_WAIT_L(0); PG8_BAR; MA(0, 0, At, B0); MA(0, 1, At, B1); PG8_BAR; PG8_SCHED; \
            PG8_LDA(At, 0, 1); PG8_STAGE(PG8_SB(0, 0), b2, voffB); PG8_STAGE(PG8_SB(0, 1), b2 + hB, voffB); PG8_STAGE_A(PG8_SA(0, 0), a2, 0); \
            PG8_WAIT_V(8); PG8_WAIT_L(0); PG8_BAR; MB(1, 0, At, B0); MB(1, 1, At, B1); PG8_BAR; PG8_SCHED; \
            PG8_LDB(B0, 1, 0); PG8_LDB(B1, 1, 1); PG8_SCHED; PG8_LDA(At, 1, 0); PG8_STAGE_A(PG8_SA(0, 1), a2, 1); \
            PG8_WAIT_V(8); PG8_WAIT_L(0); PG8_BAR; PG8_MMA(0, 0, At, B0); PG8_MMA(0, 1, At, B1); PG8_BAR; PG8_SCHED; \
            PG8_LDA(At, 1, 1); PG8_STAGE(PG8_SB(1, 0), b3, voffB); PG8_STAGE(PG8_SB(1, 1), b3 + hB, voffB); PG8_STAGE_A(PG8_SA(1, 0), a3, 0); \
            PG8_WAIT_V(8); PG8_WAIT_L(0); PG8_BAR; PG8_MMA(1, 0, At, B0); PG8_MMA(1, 1, At, B1); PG8_BAR; PG8_SCHED; }
        if constexpr (Epi::PEEL == 2) { { const int t = 0; PG8_TRIPBODY(PG8_MMA0, PG8_MMA0) } for (int t = 2; t < nt; t += 2) PG8_TRIPBODY(PG8_MMA, PG8_MMA) }
        else if constexpr (Epi::PEEL == 1) { { const int t = 0; PG8_TRIPBODY(PG8_MMA0, PG8_MMA) } for (int t = 2; t < nt; t += 2) PG8_TRIPBODY(PG8_MMA, PG8_MMA) }
        else { for (int t = 0; t < nt; t += 2) PG8_TRIPBODY(PG8_MMA, PG8_MMA) }
#undef PG8_TRIPBODY
        if (wr == 0) PG8_BAR;
        { int ln_; asm volatile("v_mbcnt_lo_u32_b32 %0, -1, 0\n\tv_mbcnt_hi_u32_b32 %0, -1, %0" : "=v"(ln_));
          if constexpr (GA) { Unit t2; int r2[4] = {0, 0, 0, 0}; const bool has2 = has_next && S.next(ui + 2, t2);
              if (has2) { const int tid2 = wid * 64 + ln_;
#pragma unroll
                  for (int i = 0; i < 2; ++i) { int R, C; stage_rc(tid2 * 16 + i * 8192, R, C);
#pragma unroll
                      for (int h = 0; h < 2; ++h) r2[h * 2 + i] = t2.rows[h * HALF + R]; } }
              float scn_ = 0.f; if constexpr (Epi::SC) { if (has_next && wid < 4) scn_ = E.scale_of(nxt, wid * 64 + ln_); }
              E(acc, cur, wr, wc, ln_ & 15, ln_ >> 4, (LAS const float*)(lds + SC_LDS_OFF) + (ui & 1) * 256);
              if constexpr (Epi::SC) { if (has_next && wid < 4) { int l4_; asm volatile("v_mbcnt_lo_u32_b32 %0, -1, 0\n\tv_mbcnt_hi_u32_b32 %0, -1, %0" : "=v"(l4_)); ((LAS float*)(lds + SC_LDS_OFF))[((ui + 1) & 1) * 256 + wid * 64 + l4_] = scn_; } }
              if (has2) { int l2_; asm volatile("v_mbcnt_lo_u32_b32 %0, -1, 0\n\tv_mbcnt_hi_u32_b32 %0, -1, %0" : "=v"(l2_)); const int tid2 = wid * 64 + l2_; u32x4 o4;
                  { int R, C; stage_rc(tid2 * 16, R, C); o4.x = (unsigned)(r2[0] * g.ldaB + C * 2); o4.z = (unsigned)(r2[2] * g.ldaB + C * 2); }
                  { int R, C; stage_rc(tid2 * 16 + 8192, R, C); o4.y = (unsigned)(r2[1] * g.ldaB + C * 2); o4.w = (unsigned)(r2[3] * g.ldaB + C * 2); }
                  *((LAS u32x4*)(lds + IX_LDS_OFF) + tid2) = o4; } }
          else { float scn_ = 0.f; if constexpr (Epi::SC) { if (has_next && wid < 4) scn_ = E.scale_of(nxt, wid * 64 + ln_); }
              E(acc, cur, wr, wc, ln_ & 15, ln_ >> 4, (LAS const float*)(lds + SC_LDS_OFF) + (ui & 1) * 256);
              if constexpr (Epi::SC) { if (has_next && wid < 4) { int l4_; asm volatile("v_mbcnt_lo_u32_b32 %0, -1, 0\n\tv_mbcnt_hi_u32_b32 %0, -1, %0" : "=v"(l4_)); ((LAS float*)(lds + SC_LDS_OFF))[((ui + 1) & 1) * 256 + wid * 64 + l4_] = scn_; } } } }
        if (!has_next) break;
        if constexpr (Epi::PEEL != 2) {
#pragma unroll
        for (int a = Epi::PEEL; a < 2; ++a)
#pragma unroll
            for (int b = 0; b < 2; ++b)
#pragma unroll
                for (int m = 0; m < 4; ++m)
#pragma unroll
                    for (int n = 0; n < 2; ++n) { double d0_, d1_; asm volatile("v_mov_b64 %0, 0\n\tv_mov_b64 %1, 0" : "=v"(d0_), "=v"(d1_)); acc[a][b][m][n] = __builtin_bit_cast(f32x4, (f64x2_){d0_, d1_}); } }
        cur = nxt; cA = nA; cB = nB; ++ui;
        if (wr == 1) PG8_BAR;
    }
    PG8_WAIT_V(0);
    PG8_BAR;
#undef PG8_SA
#undef PG8_SB
#undef PG8_STAGE
#undef PG8_STAGE_A
#undef PG8_LDA
#undef PG8_LDB
#undef PG8_MMA
#undef PG8_MMA0
#undef PG8_WAIT_V
#undef PG8_WAIT_L
#undef PG8_BAR
#undef PG8_SCHED
}
}

using pg8::Unit;
typedef f32x4 Acc[2][2][4][2];

__device__ __forceinline__ float stats_inv(const float* stats, int row) {
    const f32x4* p = (const f32x4*)(stats + (size_t)row * 16); const f32x4 a = p[0], b = p[1], c = p[2], d = p[3];
    const float s = (((a[0] + a[1]) + (a[2] + a[3])) + ((b[0] + b[1]) + (b[2] + b[3]))) + (((c[0] + c[1]) + (c[2] + c[3])) + ((d[0] + d[1]) + (d[2] + d[3])));
    return __builtin_amdgcn_rsqf(s * (1.0f / D) + RMS_EPS);
}
#define LOAD_SC8(inv) do { _Pragma("unroll") for (int ai_ = 0; ai_ < 2; ++ai_) _Pragma("unroll") for (int m_ = 0; m_ < 4; ++m_) inv[ai_][m_] = sc[ai_ * 128 + wr * 64 + m_ * 16 + fr]; } while (0)
__device__ __forceinline__ u32x4 pack8(const f32x4 a, const f32x4 b) { u32x4 w; w.x = pk2(a[0], a[1]); w.y = pk2(a[2], a[3]); w.z = pk2(b[0], b[1]); w.w = pk2(b[2], b[3]); return w; }

struct EpiInProj {
    static constexpr bool PERM = true, SC = true; static constexpr int PEEL = 0;
    const float* stats; bf16* UZ; bf16* V;
    __device__ __forceinline__ float scale_of(const Unit& u, int r) const { return stats_inv(stats, u.pm * 256 + r); }
    __device__ __forceinline__ void operator()(const Acc& acc, const Unit& u, int wr, int wc, int fr, int fq, LAS const float* sc) const {
        const int row0 = u.pm * 256 + wr * 64 + fr; float inv[2][4]; LOAD_SC8(inv);
#pragma unroll
        for (int ai = 0; ai < 2; ++ai)
#pragma unroll
            for (int m = 0; m < 4; ++m) { const int row = row0 + ai * 128 + m * 16; const float s = inv[ai][m];
#pragma unroll
                for (int bj = 0; bj < 2; ++bj) { const int c8 = u.pn * 256 + bj * 128 + wc * 32 + 8 * fq; const u32x4 w = pack8(acc[ai][bj][m][0] * s, acc[ai][bj][m][1] * s);
                    if (u.pn < 2) { const int head = c8 >> 4, g0 = c8 & 15; *(u32x4*)(UZ + ((size_t)(head * NR + (row >> 4)) * UZK + (row & 15) * 16 + g0)) = w; }
                    else *(u32x4*)(V + (size_t)row * DPOOL + (c8 - 512)) = w; } }
    }
};
struct EpiE {
    static constexpr bool PERM = false, SC = false; static constexpr int PEEL = 0;
    float* E;
    __device__ __forceinline__ void operator()(const Acc& acc, const Unit& u, int wr, int wc, int fr, int fq, LAS const float* sc) const {
#pragma unroll
        for (int ai = 0; ai < 2; ++ai)
#pragma unroll
            for (int m = 0; m < 4; ++m) { const int row = u.pm * 256 + ai * 128 + wr * 64 + m * 16 + fr; float* rp = E + ((size_t)(u.x * NR + row)) * 128 + wc * 32 + 4 * fq;
#pragma unroll
                for (int n = 0; n < 2; ++n) *(f32x4*)(rp + 16 * n) = acc[ai][0][m][n]; }
    }
};
struct EpiY {
    static constexpr bool PERM = true, SC = false; static constexpr int PEEL = 0;
    bf16* H;
    __device__ __forceinline__ void operator()(const Acc& acc, const Unit& u, int wr, int wc, int fr, int fq, LAS const float* sc) const {
#pragma unroll
        for (int ai = 0; ai < 2; ++ai)
#pragma unroll
            for (int m = 0; m < 4; ++m) { const int R = u.pm * 256 + ai * 128 + wr * 64 + m * 16 + fr;
#pragma unroll
                for (int bj = 0; bj < 2; ++bj) { const int c8 = bj * 128 + wc * 32 + 8 * fq, j = c8 >> 4, g0 = c8 & 15; f32x4 a = acc[ai][bj][m][0], b = acc[ai][bj][m][1];
#pragma unroll
                    for (int q = 0; q < 4; ++q) { a[q] = gelu_tanh(a[q]); b[q] = gelu_tanh(b[q]); }
                    *(u32x4*)(H + (size_t)(R * TC + j) * DSSM + u.x * SG + g0) = pack8(a, b); } }
    }
};
struct EpiGlu {
    static constexpr bool PERM = true, SC = false; static constexpr int PEEL = 0;
    const bf16* H; const float* bglu; bf16* MIXED;
    __device__ __forceinline__ void operator()(const Acc& acc, const Unit& u, int wr, int wc, int fr, int fq, LAS const float* sc) const {
        u32x4 hv[2][2][4]; f32x4 bb[2][2];
#pragma unroll
        for (int bj = 0; bj < 2; ++bj) { const int c8 = u.pn * 256 + bj * 128 + wc * 32 + 8 * fq; bb[bj][0] = *(const f32x4*)(bglu + c8) * -1.4426950408889634f; bb[bj][1] = *(const f32x4*)(bglu + c8 + 4) * -1.4426950408889634f;
#pragma unroll
            for (int ai = 0; ai < 2; ++ai)
#pragma unroll
                for (int m = 0; m < 4; ++m) hv[bj][ai][m] = *(const u32x4*)(H + (size_t)(u.pm * 256 + ai * 128 + wr * 64 + m * 16 + fr) * DSSM + c8); }
#pragma unroll
        for (int bj = 0; bj < 2; ++bj) { const int c8 = u.pn * 256 + bj * 128 + wc * 32 + 8 * fq; const f32x4 b0 = bb[bj][0], b1 = bb[bj][1];
#pragma unroll
            for (int ai = 0; ai < 2; ++ai)
#pragma unroll
                for (int m = 0; m < 4; ++m) { const int row = u.pm * 256 + ai * 128 + wr * 64 + m * 16 + fr; const u32x4 hw = hv[bj][ai][m];
                    const f32x4 a = acc[ai][bj][m][0] + b0, b = acc[ai][bj][m][1] + b1; f32x4 oa, ob;
                    oa[0] = bf_lo(hw.x) * __builtin_amdgcn_rcpf(1.0f + __builtin_amdgcn_exp2f(a[0])); oa[1] = bf_hi(hw.x) * __builtin_amdgcn_rcpf(1.0f + __builtin_amdgcn_exp2f(a[1])); oa[2] = bf_lo(hw.y) * __builtin_amdgcn_rcpf(1.0f + __builtin_amdgcn_exp2f(a[2])); oa[3] = bf_hi(hw.y) * __builtin_amdgcn_rcpf(1.0f + __builtin_amdgcn_exp2f(a[3]));
                    ob[0] = bf_lo(hw.z) * __builtin_amdgcn_rcpf(1.0f + __builtin_amdgcn_exp2f(b[0])); ob[1] = bf_hi(hw.z) * __builtin_amdgcn_rcpf(1.0f + __builtin_amdgcn_exp2f(b[1])); ob[2] = bf_lo(hw.w) * __builtin_amdgcn_rcpf(1.0f + __builtin_amdgcn_exp2f(b[2])); ob[3] = bf_hi(hw.w) * __builtin_amdgcn_rcpf(1.0f + __builtin_amdgcn_exp2f(b[3]));
                    *(u32x4*)(MIXED + (size_t)row * D + c8) = pack8(oa, ob); } }
    }
};
struct EpiRes {
    static constexpr bool PERM = true, SC = false; static constexpr int PEEL = 0; static constexpr int SCALE_A = 0x7d7d7d7d, SCALE_B = 0x79797979;
    const float* srcf; bf16* XB; float* stats; unsigned char* XB8;
    __device__ __forceinline__ void operator()(const Acc& acc, const Unit& u, int wr, int wc, int fr, int fq, LAS const float* sc) const {
        const size_t off0 = (size_t)(u.pm * 256 + wr * 64 + fr) * D + u.pn * 256 + wc * 32 + 8 * fq;
        f32x4 pa[8], pb[8];
#define RES_LOAD(dstv, b) do { _Pragma("unroll") for (int mm = 0; mm < 2; ++mm) _Pragma("unroll") for (int bj = 0; bj < 2; ++bj) { \
            const size_t o_ = off0 + (size_t)(((b) >> 1) * 128 + (((b) & 1) * 2 + mm) * 16) * D + bj * 128; \
            if (srcf) { dstv[(mm * 2 + bj) * 2] = __builtin_nontemporal_load((const f32x4*)(srcf + o_)); dstv[(mm * 2 + bj) * 2 + 1] = __builtin_nontemporal_load((const f32x4*)(srcf + o_ + 4)); } \
            else { const u32x4 w_ = *(const u32x4*)(XB + o_); dstv[(mm * 2 + bj) * 2] = (f32x4){bf_lo(w_.x), bf_hi(w_.x), bf_lo(w_.y), bf_hi(w_.y)}; dstv[(mm * 2 + bj) * 2 + 1] = (f32x4){bf_lo(w_.z), bf_hi(w_.z), bf_lo(w_.w), bf_hi(w_.w)}; } } } while (0)
#define RES_DO(srcv, b) do { _Pragma("unroll") for (int mm = 0; mm < 2; ++mm) { const int ai = (b) >> 1, m = ((b) & 1) * 2 + mm; const int row = u.pm * 256 + ai * 128 + wr * 64 + m * 16 + fr; float ss = 0.f; \
            _Pragma("unroll") for (int bj = 0; bj < 2; ++bj) { const size_t o = off0 + (size_t)(ai * 128 + m * 16) * D + bj * 128; \
                const f32x4 h0 = srcv[(mm * 2 + bj) * 2] + acc[ai][bj][m][0], h1 = srcv[(mm * 2 + bj) * 2 + 1] + acc[ai][bj][m][1]; \
                *(u32x4*)(XB + o) = pack8(h0, h1); \
                if (XB8) { u32x2 w8; w8.x = pk4_fp8(h0[0], h0[1], h0[2], h0[3]); w8.y = pk4_fp8(h1[0], h1[1], h1[2], h1[3]); *(u32x2*)(XB8 + o) = w8; } \
                ss += ((h0[0] * h0[0] + h0[1] * h0[1]) + (h0[2] * h0[2] + h0[3] * h0[3])) + ((h1[0] * h1[0] + h1[1] * h1[1]) + (h1[2] * h1[2] + h1[3] * h1[3])); } \
            { const int lane = fq * 16 + fr; ss += shx(ss, lane, 16); ss += shx(ss, lane, 32); if (fq == 0) stats[(size_t)row * 16 + u.pn * 4 + wc] = ss; } } } while (0)
        RES_LOAD(pa, 0);
        RES_LOAD(pb, 1); RES_DO(pa, 0);
        RES_LOAD(pa, 2); RES_DO(pb, 1);
        RES_LOAD(pb, 3); RES_DO(pa, 2);
        RES_DO(pb, 3);
#undef RES_LOAD
#undef RES_DO
    }
};
struct EpiUp {
    static constexpr bool PERM = false, SC = true; static constexpr int PEEL = 2;
    const float* stats; unsigned char* HID;
    __device__ __forceinline__ float scale_of(const Unit& u, int r) const { return stats_inv(stats, u.pm * 256 + r); }
    __device__ __forceinline__ void operator()(const Acc& acc, const Unit& u, int wr, int wc, int fr, int fq, LAS const float* sc) const {
        const int row0 = u.pm * 256 + wr * 64 + fr; float inv[2][4]; LOAD_SC8(inv);
#pragma unroll
        for (int ai = 0; ai < 2; ++ai)
#pragma unroll
            for (int m = 0; m < 4; ++m) { const int row = row0 + ai * 128 + m * 16; const float s = inv[ai][m]; f32x4 o[2];
                const float s2 = s * s;
#pragma unroll
                for (int bj = 0; bj < 2; ++bj) { const f32x4 ag = acc[ai][bj][m][0], au = acc[ai][bj][m][1];
#pragma unroll
                    for (int q = 0; q < 4; ++q) o[bj][q] = ((ag[q] * au[q]) * s2) * __builtin_amdgcn_rcpf(1.0f + __builtin_amdgcn_exp2f(ag[q] * s)); }
                { u32x2 w; w.x = pk4_fp8(o[0][0], o[0][1], o[0][2], o[0][3]); w.y = pk4_fp8(o[1][0], o[1][1], o[1][2], o[1][3]); *(u32x2*)(HID + (size_t)row * DFF + u.pn * 128 + wc * 32 + 8 * fq) = w; } }
    }
};
struct EpiUpMoe {
    static constexpr bool PERM = false, SC = false; static constexpr int PEEL = 1; static constexpr int SCALE_A = 0x7c7c7c7c, SCALE_B = 0x79797979;
    unsigned char* HID8;
    __device__ __forceinline__ void operator()(const Acc& acc, const Unit& u, int wr, int wc, int fr, int fq, LAS const float* sc) const {
#pragma unroll
        for (int ai = 0; ai < 2; ++ai)
#pragma unroll
            for (int m = 0; m < 4; ++m) { const int rl = ai * 128 + wr * 64 + m * 16 + fr; const int row = u.x + rl; f32x4 o[2];
#pragma unroll
                for (int bj = 0; bj < 2; ++bj) { const f32x4 ag = acc[ai][bj][m][0], au = acc[ai][bj][m][1];
#pragma unroll
                    for (int q = 0; q < 4; ++q) o[bj][q] = (ag[q] * au[q]) * __builtin_amdgcn_rcpf(1.0f + __builtin_amdgcn_exp2f(ag[q])); }
                if (rl < u.valid) { u32x2 w; w.x = pk4_fp8(o[0][0], o[0][1], o[0][2], o[0][3]); w.y = pk4_fp8(o[1][0], o[1][1], o[1][2], o[1][3]); *(u32x2*)(HID8 + (size_t)row * DFF + u.pn * 128 + wc * 32 + 8 * fq) = w; } }
    }
};
struct EpiDownMoe {
    static constexpr bool PERM = true, SC = false; static constexpr int PEEL = 2; static constexpr int SCALE_A = 0x7d7d7d7d, SCALE_B = 0x79797979;
    bf16* Y;
    __device__ __forceinline__ void operator()(const Acc& acc, const Unit& u, int wr, int wc, int fr, int fq, LAS const float* sc) const {
#pragma unroll
        for (int ai = 0; ai < 2; ++ai)
#pragma unroll
            for (int m = 0; m < 4; ++m) { const int rl = ai * 128 + wr * 64 + m * 16 + fr; const int row = u.x + rl;
                if (rl < u.valid) {
#pragma unroll
                    for (int bj = 0; bj < 2; ++bj) *(u32x4*)(Y + (size_t)row * D + u.pn * 256 + bj * 128 + wc * 32 + 8 * fq) = pack8(acc[ai][bj][m][0], acc[ai][bj][m][1]); } }
    }
};

#define XB_TMO      128
#define XB_XCNT(j)  (256  + 64 * (j))
#define XB_XSUB(j)  (1280 + 64 * (j))
#define XB_XGEN(j)  (2304 + 64 * (j))
#define XB_TOP      3328
#define XB_TOPGEN   3392
#define XCD_BAR_WORDS 3456
#define XB_SPIN_CAP (1u << 18)
__device__ __forceinline__ unsigned xb_ld(unsigned* p)              { return __hip_atomic_load(p, __ATOMIC_RELAXED, __HIP_MEMORY_SCOPE_AGENT); }
__device__ __forceinline__ unsigned xb_add(unsigned* p, unsigned v) { return __hip_atomic_fetch_add(p, v, __ATOMIC_RELAXED, __HIP_MEMORY_SCOPE_AGENT); }
__device__ __forceinline__ unsigned xb_xcc_id() { return (unsigned)__builtin_amdgcn_s_getreg((3 << 11) | 20) & 0xFu; }
#define XB_SPIN(cond, bar) do { unsigned _sp = 0; while (cond) { __builtin_amdgcn_s_sleep(1); \
    if ((++_sp & 255u) == 0u) { if (xb_ld(&(bar)[XB_TMO])) break; if (_sp > XB_SPIN_CAP) { atomicAdd(&(bar)[XB_TMO], 1u); break; } } } } while (0)
struct XcdBarrier { unsigned* bar; unsigned x; volatile LAS unsigned* st; };
__device__ __forceinline__ XcdBarrier xcd_barrier_post(unsigned* bar, volatile LAS unsigned* st) {
    XcdBarrier b; b.bar = bar; b.x = xb_xcc_id(); b.st = st;
    if (threadIdx.x == 0) (void)xb_add(&bar[XB_XCNT(b.x)], 1u);
    return b;
}
__device__ __forceinline__ void xcd_barrier_complete(unsigned* bar, unsigned x, unsigned& nloc, unsigned& nx) {
    const unsigned G = gridDim.x * gridDim.y * gridDim.z;
    unsigned sum, cnt, mine, sp = 0u;
    for (;;) {
        sum = 0u; cnt = 0u; mine = 0u;
#pragma unroll
        for (unsigned j = 0; j < 16; ++j) { const unsigned c = xb_ld(&bar[XB_XCNT(j)]); sum += c; cnt += (c > 0u) ? 1u : 0u; mine = (j == x) ? c : mine; }
        if (sum == G) break;
        __builtin_amdgcn_s_sleep(1);
        if ((++sp & 255u) == 0u) { if (xb_ld(&bar[XB_TMO])) break; if (sp > XB_SPIN_CAP) { atomicAdd(&bar[XB_TMO], 1u); break; } }
    }
    nloc = mine > 0u ? mine : 1u; nx = cnt > 0u ? cnt : 1u;
}
__device__ __forceinline__ void xcd_barrier(const XcdBarrier& b, const bool t0  ) {
    asm volatile("s_waitcnt vmcnt(0)" ::: "memory");
    __syncthreads();
    if (t0) {
        unsigned* bar = b.bar;
        __builtin_amdgcn_s_waitcnt(0);
        __builtin_amdgcn_fence(__ATOMIC_ACQUIRE, "agent");
        unsigned nloc = b.st[0], nx = b.st[1];
        if (nloc == 0u) { xcd_barrier_complete(bar, b.x, nloc, nx); b.st[0] = nloc; b.st[1] = nx; }
        const unsigned old = xb_add(&bar[XB_XSUB(b.x)], 1u);
        const unsigned gen = old / nloc;
        if (old + 1u == (gen + 1u) * nloc) {
            __builtin_amdgcn_fence(__ATOMIC_RELEASE, "agent");
            asm volatile("s_waitcnt vmcnt(0)" ::: "memory");
            const unsigned og = xb_add(&bar[XB_TOP], 1u);
            const unsigned tg = og / nx;
            if (og + 1u == (tg + 1u) * nx) {
#pragma unroll
                for (unsigned j = 0; j < 16; ++j) xb_add(&bar[XB_XGEN(j)], 1u); }
            else XB_SPIN(xb_ld(&bar[XB_XGEN(b.x)]) == gen, bar);
            asm volatile("s_waitcnt vmcnt(0)" ::: "memory");
        } else {
            XB_SPIN(xb_ld(&bar[XB_XGEN(b.x)]) == gen, bar);
            asm volatile("s_waitcnt vmcnt(0)" ::: "memory");
        }
    }
    __syncthreads();
}

struct Ptrs {
    const float* in[25]; float* out; unsigned char* ws;
};
typedef const float* kfptr_t;
__device__ __forceinline__ const float* kin(int i) { const __attribute__((address_space(4))) kfptr_t* kp = (const __attribute__((address_space(4))) kfptr_t*)__builtin_amdgcn_kernarg_segment_ptr(); asm volatile("" : "+s"(i)); return kp[i]; }
__device__ __forceinline__ float* kout() { return (float*)kin(25); }
__device__ __forceinline__ unsigned char* kws() { return (unsigned char*)kin(26); }
__device__ __forceinline__ unsigned char* pg8::kws_() { return kws(); }
__device__ __forceinline__ int gu_row(int j, int ty) { return 256 * (j >> 7) + 128 * ((j >> 2) & 1) + 32 * ((j >> 5) & 3) + 16 * ty + 4 * ((j >> 3) & 3) + (j & 3); }

struct TrItem { const float* W; bf16* WT; const float* gk; int ldw, nblk, ldt, ty, r; float cm; };
__device__ __forceinline__ void tr_load(const TrItem& t, f32x4 (&v)[16], int lane) {
    const int kb = t.r / t.nblk, nb = t.r - kb * t.nblk;
    const float* src = t.W + (size_t)(64 * kb + (lane >> 4)) * t.ldw + 64 * nb + 4 * (lane & 15);
#pragma unroll
    for (int i = 0; i < 16; ++i) v[i] = __builtin_nontemporal_load((const f32x4*)(src + (size_t)(4 * i) * t.ldw));
}
__device__ __forceinline__ void tr_gains(const TrItem& t, float (&gs)[8], int lane) { const int kb = t.r / t.nblk, k0 = 64 * kb, c = lane >> 3;
#pragma unroll
    for (int e = 0; e < 8; ++e) gs[e] = t.cm * (t.gk ? t.gk[k0 + 8 * c + e] : 1.0f); }
__device__ __forceinline__ void tr_finish(const TrItem& t, const f32x4 (&v)[16], const float (&gs)[8], LAS float* scr, int lane) {
    const int kb = t.r / t.nblk, nb = t.r - kb * t.nblk, k0 = 64 * kb, n0 = 64 * nb;
#pragma unroll
    for (int i = 0; i < 16; ++i) { const int kk = (lane >> 4) + 4 * i; *(LAS f32x4*)(scr + kk * 64 + ((4 * (lane & 15)) ^ (8 * ((kk >> 3) & 3)))) = v[i]; }
    LDS_WAIT(); asm volatile("" ::: "memory");
    {
    const int c = lane >> 3, nl = lane & 7;
#pragma unroll
    for (int j = 0; j < 8; ++j) { const int n = nl + 8 * j; const LAS float* sp = scr + (8 * c) * 64 + (n ^ (8 * (c & 3)));
        u32x4 o; o.x = pk2(sp[0 * 64] * gs[0], sp[1 * 64] * gs[1]); o.y = pk2(sp[2 * 64] * gs[2], sp[3 * 64] * gs[3]); o.z = pk2(sp[4 * 64] * gs[4], sp[5 * 64] * gs[5]); o.w = pk2(sp[6 * 64] * gs[6], sp[7 * 64] * gs[7]);
        const int dr = t.ty < 0 ? (n0 + n) : gu_row(n0 + n, t.ty);
        *(u32x4*)(t.WT + (size_t)dr * t.ldt + k0 + 8 * c) = o; }
    }
    LDS_WAIT(); asm volatile("" ::: "memory");
}
__device__ __forceinline__ TrItem pro_item(int q, unsigned char* ws) {
    TrItem t; t.cm = 1.0f;
    if (q < 896) { const int l = q / 448; int r = q - l * 448;
        if (r < 128) { t.W = kin(2) + (size_t)l * D * D; t.ldw = D; t.nblk = 8; t.WT = (bf16*)(ws + WS_WIN) + (size_t)l * D * D; t.ldt = D; t.gk = kin(1) + l * D; t.ty = -1; t.r = r; return t; } r -= 128;
        if (r < 64) { t.W = kin(11) + (size_t)l * 512 * 512; t.ldw = 512; t.nblk = 8; t.WT = (bf16*)(ws + WS_WGLU) + (size_t)l * 512 * 512; t.ldt = 512; t.gk = nullptr; t.ty = -1; t.r = r; t.cm = -1.4426950408889634f; return t; } r -= 64;
        t.W = kin(15) + (size_t)l * D * D; t.ldw = D; t.nblk = 16; t.WT = (bf16*)(ws + WS_WOUT) + (size_t)l * D * D; t.ldt = D; t.gk = nullptr; t.ty = -1; t.r = r; return t; }
    const int qq = q - 896, mi = qq / 704; t.r = qq - mi * 704;
    if (mi == 2) { t.W = kin(19); t.ldw = D; t.nblk = 16; t.WT = (bf16*)(ws + WS_WD); t.ldt = DFF; t.gk = nullptr; t.ty = -1; }
    else { t.W = mi == 0 ? kin(17) : kin(18); t.ldw = DFF; t.nblk = 44; t.WT = (bf16*)(ws + WS_WGU); t.ldt = D; t.gk = kin(16); t.ty = mi; t.cm = mi == 0 ? -1.4426950408889634f : -2.772588722239781f; }
    return t;
}
__device__ __forceinline__ void tr_run(unsigned char* ws, LAS float* scr, int first, int step, int it1, int lane) {
    int it = first; if (it >= it1) return;
    TrItem cur = pro_item(it, ws); f32x4 vc[16]; tr_load(cur, vc, lane);
    for (;;) { const int nx = it + step; const bool more = nx < it1; TrItem nxt = cur; f32x4 vn[16];
        float gs[8]; tr_gains(cur, gs, lane);
        if (more) { nxt = pro_item(nx, ws); tr_load(nxt, vn, lane); }
        tr_finish(cur, vc, gs, scr, lane);
        if (!more) break;
        cur = nxt; it = nx;
#pragma unroll
        for (int i = 0; i < 16; ++i) vc[i] = vn[i]; }
}

__device__ __forceinline__ void ssm_tables_item(int item, LAS unsigned char* lds, int tid) {
    const int lh = item >> 2, q = item & 3;
    LAS float* lp_re = (LAS float*)lds;
    LAS float* lp_im = lp_re + 17 * 64;
    LAS float* cf_re = lp_im + 17 * 64;
    LAS float* cf_im = cf_re + 64;
    LAS float* bb_re = cf_im + 64;
    LAS float* bb_im = bb_re + 1024;
    LAS float* Kt = bb_im + 1024;
    LAS float* cq_re = Kt + 1024;
    LAS float* cq_im = cq_re + 256;
    const float dt = expf(kin(3)[lh]);
    const float* a_re = kin(4) + (size_t)lh * 64; const float* a_im = kin(5) + (size_t)lh * 64;
    const float* b_re = kin(6) + (size_t)lh * 1024; const float* b_im = kin(7) + (size_t)lh * 1024;
    const float* c_re = kin(8) + (size_t)lh * 1024 + q * 256; const float* c_im = kin(9) + (size_t)lh * 1024 + q * 256;
    const float* dd = kin(10) + (size_t)lh * 16;
    bf16* TW = (bf16*)(kws() + WS_TW) + (size_t)lh * 256 * UZK;
    bf16* WE = (bf16*)(kws() + WS_WE) + (size_t)lh * 256 * 256;
    float* LT = (float*)(kws() + WS_LAMT) + (size_t)lh * 128;
    const float pb_re0 = b_re[tid], pb_im0 = b_im[tid], pb_re1 = b_re[tid + 512], pb_im1 = b_im[tid + 512];
    const float pc_re = c_re[tid & 255], pc_im = c_im[tid & 255], pdd = dd[4 * q + ((tid >> 2) & 3)];
    const float pa_re0 = a_re[tid & 63], pa_im0 = a_im[tid & 63];
    __syncthreads();
    for (int idx = tid; idx < 17 * 64; idx += 512) {
        const int k = idx >> 6, p = idx & 63;
        const float ar = fminf(pa_re0, -1e-4f), ai = pa_im0;
        const float mag = __builtin_amdgcn_exp2f(ar * dt * (float)k * 1.4426950408889634f);
        float rev = ai * dt * (float)k * 0.15915494309189535f; rev -= floorf(rev);
        const float sn = __builtin_amdgcn_sinf(rev), cs = __builtin_amdgcn_cosf(rev);
        lp_re[idx] = mag * cs; lp_im[idx] = mag * sn;
        if (k == 1) { const float lr = mag * cs, li = mag * sn, den = ar * ar + ai * ai, nr = lr - 1.0f, ni = li;
            cf_re[p] = (nr * ar + ni * ai) / den; cf_im[p] = (ni * ar - nr * ai) / den; }
        if (k == 16 && q == 0) { LT[2 * p] = mag * cs; LT[2 * p + 1] = mag * sn; }
    }
    if (tid < 256) { cq_re[tid] = pc_re; cq_im[tid] = pc_im; }
    __syncthreads();
#pragma unroll
    for (int h = 0; h < 2; ++h) { const int idx = tid + 512 * h, p = idx >> 4; const float br = h ? pb_re1 : pb_re0, bi = h ? pb_im1 : pb_im0, cr = cf_re[p], ci = cf_im[p];
        bb_re[idx] = cr * br - ci * bi; bb_im[idx] = cr * bi + ci * br; }
    __syncthreads();
    if (tid < 256) { const int k = tid >> 4, gl = (tid >> 2) & 3, g4 = tid & 3; f32x4 s = (f32x4){0.f, 0.f, 0.f, 0.f};
#pragma unroll 2
        for (int p0 = 0; p0 < 64; p0 += 4) { const f32x4 cr4 = *(const LAS f32x4*)(cq_re + gl * 64 + p0), ci4 = *(const LAS f32x4*)(cq_im + gl * 64 + p0), wr4 = *(const LAS f32x4*)(lp_re + k * 64 + p0), wi4 = *(const LAS f32x4*)(lp_im + k * 64 + p0);
#pragma unroll
            for (int j = 0; j < 4; ++j) { const float xr = cr4[j] * wr4[j] - ci4[j] * wi4[j], xi = cr4[j] * wi4[j] + ci4[j] * wr4[j];
                const f32x4 br = *(const LAS f32x4*)(bb_re + (p0 + j) * 16 + 4 * g4), bi = *(const LAS f32x4*)(bb_im + (p0 + j) * 16 + 4 * g4); s += xr * br - xi * bi; } }
        if (k == 0 && ((4 * q + gl) >> 2) == g4) s[(4 * q + gl) & 3] += pdd;
        *(LAS f32x4*)(Kt + k * 64 + gl * 16 + 4 * g4) = s; }
    __syncthreads();
    for (int ch = tid; ch < 64 * 48; ch += 512) { const int nr = ch / 48, cc = ch - nr * 48, j = nr >> 2, gl = nr & 3, n = j * 16 + 4 * q + gl, col8 = cc * 8; f32x4 v0, v1;
        if (col8 < 256) { const int i = col8 >> 4, gi0 = col8 & 15;
            if (i <= j) { const LAS f32x4* kp = (const LAS f32x4*)(Kt + ((j - i) * 4 + gl) * 16 + gi0); v0 = kp[0]; v1 = kp[1]; } else { v0 = (f32x4){0.f, 0.f, 0.f, 0.f}; v1 = v0; } }
        else { const int pp0 = col8 - 256, p0 = pp0 & 63;
            const LAS f32x4* c_r = (const LAS f32x4*)(cq_re + gl * 64 + p0); const LAS f32x4* c_i = (const LAS f32x4*)(cq_im + gl * 64 + p0);
            const LAS f32x4* w_r = (const LAS f32x4*)(lp_re + (j + 1) * 64 + p0); const LAS f32x4* w_i = (const LAS f32x4*)(lp_im + (j + 1) * 64 + p0);
            const f32x4 cr0 = c_r[0], cr1 = c_r[1], ci0 = c_i[0], ci1 = c_i[1], wr0 = w_r[0], wr1 = w_r[1], wi0 = w_i[0], wi1 = w_i[1];
            if (pp0 < 64) { v0 = cr0 * wr0 - ci0 * wi0; v1 = cr1 * wr1 - ci1 * wi1; } else { v0 = -(cr0 * wi0 + ci0 * wr0); v1 = -(cr1 * wi1 + ci1 * wr1); } }
        u32x4 o; o.x = pk2(v0[0], v0[1]); o.y = pk2(v0[2], v0[3]); o.z = pk2(v1[0], v1[1]); o.w = pk2(v1[2], v1[3]);
        *(u32x4*)(TW + (size_t)n * UZK + col8) = o; }
    for (int ch = tid; ch < 32 * 32; ch += 512) { const int pr = 32 * q + (ch >> 5), cc = ch & 31, col8 = cc * 8, i = col8 >> 4, g0 = col8 & 15, p = pr & 63;
        const float wr_ = lp_re[(15 - i) * 64 + p], wi = lp_im[(15 - i) * 64 + p];
        const LAS f32x4* b_r = (const LAS f32x4*)(bb_re + p * 16 + g0); const LAS f32x4* b_i = (const LAS f32x4*)(bb_im + p * 16 + g0);
        const f32x4 br0 = b_r[0], br1 = b_r[1], bi0 = b_i[0], bi1 = b_i[1]; f32x4 v0, v1;
        if (pr < 64) { v0 = wr_ * br0 - wi * bi0; v1 = wr_ * br1 - wi * bi1; } else { v0 = wr_ * bi0 + wi * br0; v1 = wr_ * bi1 + wi * br1; }
        u32x4 o; o.x = pk2(v0[0], v0[1]); o.y = pk2(v0[2], v0[3]); o.z = pk2(v1[0], v1[1]); o.w = pk2(v1[2], v1[3]);
        *(u32x4*)(WE + (size_t)pr * 256 + col8) = o; }
    __syncthreads();
}

__device__ __forceinline__ void pool_fold_item_rolled(const Ptrs& P, int it, LAS float* scr, int lane) {
    const int l = it >> 9, grp = (it >> 7) & 3, kb = (it >> 3) & 15, db = it & 7, k = 64 * kb + lane;
    const f32x4* row = (const f32x4*)(kin(2) + ((size_t)l * D + k) * D + 512 + 128 * grp);
    const float* pw = kin(13) + ((size_t)(l * 4 + grp) * 128) * 128 + 16 * db;
    f32x4 pv[8];
#pragma unroll
    for (int i = 0; i < 8; ++i) { const int i4 = lane + 64 * i; pv[i] = *(const f32x4*)(pw + (size_t)(i4 >> 2) * 128 + 4 * (i4 & 3)); }
    f32x4 cur[4];
#pragma unroll
    for (int i = 0; i < 4; ++i) cur[i] = row[i];
    const float gk = kin(1)[l * D + k]; float ps[16];
#pragma unroll
    for (int d = 0; d < 16; ++d) ps[d] = kin(14)[l * DPOOL + 128 * grp + 16 * db + d];
#pragma unroll
    for (int i = 0; i < 8; ++i) *(LAS f32x4*)(scr + 4 * (lane + 64 * i)) = pv[i];
    LDS_WAIT(); asm volatile("" ::: "memory");
    float acc[16];
#pragma unroll
    for (int d = 0; d < 16; ++d) acc[d] = 0.f;
#pragma unroll 1
    for (int g = 0; g < 8; ++g) { f32x4 nxt[4];
#pragma unroll
        for (int i = 0; i < 4; ++i) nxt[i] = row[4 * ((g + 1) & 7) + i];
        { const LAS f32x4* pr0 = (const LAS f32x4*)(scr + (16 * g) * 16); f32x4 qa[4];
#pragma unroll
          for (int d4 = 0; d4 < 4; ++d4) qa[d4] = pr0[d4];
#pragma unroll
          for (int ic = 0; ic < 16; ++ic) { f32x4 qb[4];
              if (ic < 15) { const LAS f32x4* pr = (const LAS f32x4*)(scr + (16 * g + ic + 1) * 16);
#pragma unroll
                  for (int d4 = 0; d4 < 4; ++d4) qb[d4] = pr[d4]; }
              const float av = cur[ic >> 2][ic & 3];
#pragma unroll
              for (int d4 = 0; d4 < 4; ++d4)
#pragma unroll
                  for (int d = 0; d < 4; ++d) asm("v_fmac_f32 %0, %1, %2" : "+v"(acc[4 * d4 + d]) : "v"(av), "v"(qa[d4][d]));
              if (ic < 15) {
#pragma unroll
                  for (int d4 = 0; d4 < 4; ++d4) qa[d4] = qb[d4]; }
              __builtin_amdgcn_sched_barrier(0); } }
#pragma unroll
        for (int i = 0; i < 4; ++i) cur[i] = nxt[i]; }
    LDS_WAIT(); asm volatile("" ::: "memory");
    bf16* WT = (bf16*)(kws() + WS_WIN) + (size_t)l * D * D;
#pragma unroll
    for (int d = 0; d < 16; ++d) { const int dl = 128 * grp + 16 * db + d; WT[(size_t)(512 + dl) * D + k] = (bf16)f2bf(acc[d] * gk * ps[d]); }
}

__device__ __forceinline__ void pool_fold_item(const Ptrs& P, int it, LAS float* scr, int lane) {
    const int l = it >> 9, grp = (it >> 7) & 3, kb = (it >> 3) & 15, db = it & 7, k = 64 * kb + lane;
    const f32x4* row = (const f32x4*)(kin(2) + ((size_t)l * D + k) * D + 512 + 128 * grp);
    const float* pw = kin(13) + ((size_t)(l * 4 + grp) * 128) * 128 + 16 * db;
    f32x4 a[32], pv[8];
#pragma unroll
    for (int i = 0; i < 8; ++i) { const int i4 = lane + 64 * i; pv[i] = *(const f32x4*)(pw + (size_t)(i4 >> 2) * 128 + 4 * (i4 & 3)); }
#pragma unroll
    for (int i = 0; i < 32; ++i) a[i] = row[i];
#pragma unroll
    for (int i = 0; i < 8; ++i) *(LAS f32x4*)(scr + 4 * (lane + 64 * i)) = pv[i];
    LDS_WAIT(); asm volatile("" ::: "memory");
    float acc[16];
#pragma unroll
    for (int d = 0; d < 16; ++d) acc[d] = 0.f;
#pragma unroll
    for (int i = 0; i < 32; ++i)
#pragma unroll
        for (int cc = 0; cc < 4; ++cc) { const LAS f32x4* pr = (const LAS f32x4*)(scr + (4 * i + cc) * 16);
#pragma unroll
            for (int d4 = 0; d4 < 4; ++d4) { const f32x4 pq = pr[d4];
#pragma unroll
                for (int d = 0; d < 4; ++d) acc[4 * d4 + d] += a[i][cc] * pq[d]; } }
    LDS_WAIT(); asm volatile("" ::: "memory");
    const float gk = kin(1)[l * D + k];
    bf16* WT = (bf16*)(kws() + WS_WIN) + (size_t)l * D * D;
#pragma unroll
    for (int d = 0; d < 16; ++d) { const int dl = 128 * grp + 16 * db + d; WT[(size_t)(512 + dl) * D + k] = (bf16)f2bf(acc[d] * gk * kin(14)[l * DPOOL + dl]); }
}

__device__ __forceinline__ void xrow_item(const float* xrow, bf16* orow, float* srow, int lane) {
    const f32x4* xr = (const f32x4*)xrow + lane; f32x4 v[4]; float s = 0.f;
#pragma unroll
    for (int j = 0; j < 4; ++j) { v[j] = xr[64 * j]; s += (v[j][0] * v[j][0] + v[j][1] * v[j][1]) + (v[j][2] * v[j][2] + v[j][3] * v[j][3]); }
    s = wave_sum(s, lane);
    u32x2* o8 = (u32x2*)orow + lane;
#pragma unroll
    for (int j = 0; j < 4; ++j) { u32x2 w; w.x = pk2(v[j][0], v[j][1]); w.y = pk2(v[j][2], v[j][3]); o8[64 * j] = w; }
    if (lane < 16) srow[lane] = lane == 0 ? s : 0.f;
}

struct Ids { int tid, lane, wave, G, bx, gw, NGW; };
__device__ __forceinline__ int hw_lane() { int l; asm volatile("v_mbcnt_lo_u32_b32 %0, -1, 0\n\tv_mbcnt_hi_u32_b32 %0, -1, %0" : "=v"(l)); return l; }
__device__ __forceinline__ Ids make_ids(int wave) {
    asm volatile("" : "+s"(wave));
    Ids I; I.lane = hw_lane(); I.wave = wave; I.tid = wave * 64 + I.lane; I.G = gridDim.x; I.bx = blockIdx.x;
    const int vcu = (I.G % 8 == 0) ? (I.bx % 8) * (I.G / 8) + I.bx / 8 : I.bx;
    I.gw = vcu * NWAVES + I.wave; I.NGW = I.G * NWAVES; return I;
}

constexpr int XT_TAB = 0, XT_OTH = 4;
__device__ __forceinline__ void p0_prologue(const Ptrs& P, LAS unsigned char* lds, int wave) {
    const Ids I = make_ids(wave); unsigned char* ws = kws();
    for (int it = I.bx; it < 128; it += I.G) ssm_tables_item(it, lds, I.tid);
    __syncthreads();
    LAS float* scr = (LAS float*)(lds + I.wave * 16384);
    if (I.G == 256) { if (I.bx < 128) { if (I.wave < 4) pool_fold_item_rolled(P, I.wave * 128 + I.bx, scr, I.lane); else if (I.wave == 4) tr_run(ws, scr, I.bx, 128, 128, I.lane); } }
    else { tr_run(ws, scr, I.gw, I.NGW, 128, I.lane); for (int it = I.gw; it < 512; it += I.NGW) pool_fold_item(P, it, scr, I.lane); }
    const bool bal = I.G == 256; const int wv = I.bx * NWAVES + I.wave, ntr = bal ? (I.bx < 128 ? XT_TAB : XT_OTH) : (M / 4 + I.NGW - 1) / I.NGW;
#define XP_TRIP(tq) (bal ? (I.bx < 128 ? wv * XT_TAB + (tq) : 1024 * XT_TAB + (wv - 1024) * XT_OTH + (tq)) : wv + (tq) * I.NGW)
#define XP_LOAD(v, trip) do { const int m0_ = 4 * (trip); _Pragma("unroll") for (int r = 0; r < 4; ++r) { const f32x4* xr = (const f32x4*)(kin(0) + (size_t)(m0_ + r) * D) + I.lane; \
        _Pragma("unroll") for (int j = 0; j < 4; ++j) v[r][j] = __builtin_nontemporal_load(xr + 64 * j); } } while (0)
#define XP_DO(v, trip) do { const int m0_ = 4 * (trip); _Pragma("unroll") for (int r = 0; r < 4; ++r) { const int m = m0_ + r; float sq = 0.f; \
        _Pragma("unroll") for (int j = 0; j < 4; ++j) sq += (v[r][j][0] * v[r][j][0] + v[r][j][1] * v[r][j][1]) + (v[r][j][2] * v[r][j][2] + v[r][j][3] * v[r][j][3]); \
        sq = wave_sum(sq, I.lane); u32x2* o8 = (u32x2*)((bf16*)(ws + WS_XB) + (size_t)m * D) + I.lane; \
        _Pragma("unroll") for (int j = 0; j < 4; ++j) { u32x2 w; w.x = pk2(v[r][j][0], v[r][j][1]); w.y = pk2(v[r][j][2], v[r][j][3]); o8[64 * j] = w; } \
        if (I.lane < 16) ((float*)(ws + WS_STATS))[(size_t)m * 16 + I.lane] = I.lane == 0 ? sq : 0.f; } } while (0)
    f32x4 va[4][4], vb[4][4];
    if (ntr > 0 && XP_TRIP(0) < M / 4) XP_LOAD(va, XP_TRIP(0));
    for (int tq = 0; tq < ntr; tq += 2) { const int t0 = XP_TRIP(tq), t1 = XP_TRIP(tq + 1), t2 = XP_TRIP(tq + 2); if (t0 >= M / 4) break;
        const bool h1 = tq + 1 < ntr && t1 < M / 4, h2 = tq + 2 < ntr && t2 < M / 4;
        if (h1) XP_LOAD(vb, t1);
        XP_DO(va, t0);
        if (!h1) break;
        if (h2) XP_LOAD(va, t2);
        XP_DO(vb, t1); }
#undef XP_TRIP
#undef XP_LOAD
#undef XP_DO
}

constexpr int MOE_TILES = 24 * 88;
struct MoeTile { const float* src; unsigned char* dst; const float* gk; int ldw, ldt, k0, n0, ty; };
__device__ __forceinline__ MoeTile moe_tile(int tile, unsigned char* ws) {
    MoeTile t;
    if (tile >= MOE_TILES) { const int r = tile - MOE_TILES, kb = r >> 2, nb = r & 3; t.ldw = D; t.src = kin(19) + (size_t)(kb * 128) * D + nb * 256; t.dst = ws + WS_WD; t.ldt = DFF; t.k0 = kb * 128; t.n0 = nb * 256; t.ty = -1; t.gk = nullptr; return t; }
    int e, kind, r; if (tile < 1408) { const int mi = tile / 88; r = tile - mi * 88; e = mi >> 1; kind = mi & 1; } else { const int d = tile - 1408; e = d / 88; r = d - e * 88; kind = 2; }
    if (kind == 2) { const int kb = r >> 2, nb = r & 3; t.ldw = D; t.src = kin(23) + (size_t)e * DFF * D + (size_t)(kb * 128) * D + nb * 256; t.dst = ws + WS_MWD + (size_t)e * D * DFF; t.ldt = DFF; t.k0 = kb * 128; t.n0 = nb * 256; t.ty = -1; t.gk = nullptr; }
    else { const int kb = r / 11, nb = r - kb * 11; t.ldw = DFF; t.src = (kind == 0 ? kin(21) : kin(22)) + (size_t)e * D * DFF + (size_t)(kb * 128) * DFF + nb * 256; t.dst = ws + WS_MWGU + (size_t)e * 2 * DFF * D; t.ldt = D; t.k0 = kb * 128; t.n0 = nb * 256; t.ty = kind; t.gk = kin(16) + D; }
    return t;
}
__device__ __forceinline__ void moe_convert_wg(LAS unsigned char* lds, int wave, int frank, int nf, int t0, int t1) {
    const Ids I = make_ids(wave); unsigned char* ws = kws(); LAS float* tl = (LAS float*)lds; const int lane = I.lane, w = I.wave;
    int tile = t0 + frank; if (tile >= t1) return;
    MoeTile cur = moe_tile(tile, ws); f32x4 v[16];
#pragma unroll
    for (int i = 0; i < 16; ++i) v[i] = __builtin_nontemporal_load((const f32x4*)(cur.src + (size_t)(16 * w + i) * cur.ldw + 4 * lane));
    for (;;) {
        __syncthreads();
        const MoeTile t = cur; const int c = lane & 7, nl = lane >> 3; float gs[16];
        const float cm = t.ty == 0 ? -64.f * 1.4426950408889634f : t.ty == 1 ? -64.f * 2.772588722239781f : 64.f;
#pragma unroll
        for (int e = 0; e < 16; ++e) gs[e] = cm * (t.gk ? t.gk[t.k0 + 16 * c + e] : 1.0f);
#pragma unroll
        for (int i = 0; i < 16; ++i) { const int k = 16 * w + i; *(LAS f32x4*)(tl + k * 256 + ((4 * lane) ^ (4 * ((k >> 4) & 7)))) = v[i]; }
        LDS_WAIT(); __syncthreads();
        const int nx = tile + nf; const bool more = nx < t1;
        if (more) { cur = moe_tile(nx, ws);
#pragma unroll
            for (int i = 0; i < 16; ++i) v[i] = __builtin_nontemporal_load((const f32x4*)(cur.src + (size_t)(16 * w + i) * cur.ldw + 4 * lane)); }
#pragma unroll
        for (int j = 0; j < 4; ++j) { const int n = 32 * w + 8 * j + nl; const LAS float* sp = tl + (16 * c) * 256 + (n ^ (4 * c));
            u32x4 o; o.x = pk4_fp8(gs[0] * sp[0 * 256], gs[1] * sp[1 * 256], gs[2] * sp[2 * 256], gs[3] * sp[3 * 256]); o.y = pk4_fp8(gs[4] * sp[4 * 256], gs[5] * sp[5 * 256], gs[6] * sp[6 * 256], gs[7] * sp[7 * 256]);
            o.z = pk4_fp8(gs[8] * sp[8 * 256], gs[9] * sp[9 * 256], gs[10] * sp[10 * 256], gs[11] * sp[11 * 256]); o.w = pk4_fp8(gs[12] * sp[12 * 256], gs[13] * sp[13 * 256], gs[14] * sp[14 * 256], gs[15] * sp[15 * 256]);
            const int dr = t.ty < 0 ? (t.n0 + n) : gu_row(t.n0 + n, t.ty);
            *(u32x4*)(t.dst + (size_t)dr * t.ldt + t.k0 + 16 * c) = o; }
        if (!more) break;
        tile = nx;
    }
    LDS_WAIT(); __syncthreads();
}

__device__ __forceinline__ void moe_subitem_wave(int tile, int sub, unsigned char* ws, LAS float* scr, int lane) {
    const MoeTile t = moe_tile(tile, ws); const int sk = sub >> 2, sn = sub & 3, k0 = t.k0 + 64 * sk, n0 = t.n0 + 64 * sn;
    const float* src = t.src + (size_t)(64 * sk + (lane >> 4)) * t.ldw + 64 * sn + 4 * (lane & 15); f32x4 v[16];
#pragma unroll
    for (int i = 0; i < 16; ++i) v[i] = __builtin_nontemporal_load((const f32x4*)(src + (size_t)(4 * i) * t.ldw));
#pragma unroll
    for (int i = 0; i < 16; ++i) { const int kk = (lane >> 4) + 4 * i; *(LAS f32x4*)(scr + kk * 64 + ((4 * (lane & 15)) ^ (8 * ((kk >> 3) & 3)))) = v[i]; }
    LDS_WAIT(); asm volatile("" ::: "memory");
    const int c = lane >> 3, nl = lane & 7; float gs[8];
    const float cm = t.ty == 0 ? -64.f * 1.4426950408889634f : t.ty == 1 ? -64.f * 2.772588722239781f : 64.f;
#pragma unroll
    for (int e = 0; e < 8; ++e) gs[e] = cm * (t.gk ? t.gk[k0 + 8 * c + e] : 1.0f);
#pragma unroll
    for (int j = 0; j < 8; ++j) { const int n = nl + 8 * j; const LAS float* sp = scr + (8 * c) * 64 + (n ^ (8 * (c & 3)));
        u32x2 o; o.x = pk4_fp8(sp[0 * 64] * gs[0], sp[1 * 64] * gs[1], sp[2 * 64] * gs[2], sp[3 * 64] * gs[3]); o.y = pk4_fp8(sp[4 * 64] * gs[4], sp[5 * 64] * gs[5], sp[6 * 64] * gs[6], sp[7 * 64] * gs[7]);
        const int dr = t.ty < 0 ? (n0 + n) : gu_row(n0 + n, t.ty);
        *(u32x2*)(t.dst + (size_t)dr * t.ldt + k0 + 8 * c) = o; }
    LDS_WAIT(); asm volatile("" ::: "memory");
}
constexpr int MF_A = 256, MF_B = MF_A + 0, MF_C = MF_B + 512, MF_D = MF_C + 384;
constexpr int MT_RT = 128;
constexpr int MT_POS = 224;
constexpr int MT_TAIL = 336, MT_END = MOE_TILES - MT_TAIL;
static_assert(MF_D < MT_END && MT_END >= 1408, "filler slots");
constexpr int PRO_SPLIT = 1280;
__device__ __forceinline__ void pro_convert(LAS unsigned char* lds, int wave, int frank, int nf, int it0 = 128, int it1 = 896 + 2 * 704) {
    const Ids I = make_ids(wave); unsigned char* ws = kws(); LAS float* scr = (LAS float*)(lds + I.wave * 16384);
    tr_run(ws, scr, it0 + frank * NWAVES + I.wave, nf * NWAVES, it1, I.lane);
}
__device__ __forceinline__ void misc_fill(const Ptrs& P, LAS unsigned char* lds, int wave, int frank, int nf) {
    const Ids I = make_ids(wave);
    for (int it = 128 + frank; it < 256; it += nf) ssm_tables_item(it, lds, I.tid);
    __syncthreads();
    LAS float* scr = (LAS float*)(lds + I.wave * 16384);
    if (nf == 128) { if (I.wave < 4) pool_fold_item_rolled(P, 512 + I.wave * 128 + frank, scr, I.lane); }
    else for (int it = 512 + frank * NWAVES + I.wave; it < 1024; it += nf * NWAVES) pool_fold_item(P, it, scr, I.lane);
}

template <int W> __device__ __forceinline__ void pool_task(const bf16* VB, bf16* MIXED, int g, int run4, int lane) {
    asm volatile("" : "+v"(lane));
    const int run = 4 * run4 + (lane >> 4), c8 = 128 * g + 8 * (lane & 15), t0 = 16 * run, tin0 = t0 & (SEQ - 1);
    const bf16* vp = VB + (size_t)t0 * DPOOL + c8;
    u32x4 v[W - 1 + 16];
#pragma unroll
    for (int i = 0; i < W - 1 + 16; ++i) { const int r = i - (W - 1); v[i] = (tin0 + r >= 0) ? *(const u32x4*)(vp + (ptrdiff_t)r * DPOOL) : (u32x4){0u, 0u, 0u, 0u}; }
    float s[8];
#pragma unroll
    for (int e = 0; e < 8; ++e) s[e] = 0.f;
#pragma unroll
    for (int i = 0; i < W - 1; ++i) { s[0] += bf_lo(v[i].x); s[1] += bf_hi(v[i].x); s[2] += bf_lo(v[i].y); s[3] += bf_hi(v[i].y); s[4] += bf_lo(v[i].z); s[5] += bf_hi(v[i].z); s[6] += bf_lo(v[i].w); s[7] += bf_hi(v[i].w); }
#pragma unroll
    for (int j = 0; j < 16; ++j) { const u32x4 c = v[W - 1 + j]; const float x[8] = {bf_lo(c.x), bf_hi(c.x), bf_lo(c.y), bf_hi(c.y), bf_lo(c.z), bf_hi(c.z), bf_lo(c.w), bf_hi(c.w)};
#pragma unroll
        for (int e = 0; e < 8; ++e) s[e] += x[e];
        const int cnt = tin0 + j + 1 < W ? tin0 + j + 1 : W; const float rc = 1.0f / (float)cnt; u32x4 o;
        o.x = pk2(s[0] * rc - x[0], s[1] * rc - x[1]); o.y = pk2(s[2] * rc - x[2], s[3] * rc - x[3]); o.z = pk2(s[4] * rc - x[4], s[5] * rc - x[5]); o.w = pk2(s[6] * rc - x[6], s[7] * rc - x[7]);
        *(u32x4*)(MIXED + (size_t)(t0 + j) * D + 512 + c8) = o;
        const u32x4 d = v[j];
        s[0] -= bf_lo(d.x); s[1] -= bf_hi(d.x); s[2] -= bf_lo(d.y); s[3] -= bf_hi(d.y); s[4] -= bf_lo(d.z); s[5] -= bf_hi(d.z); s[6] -= bf_lo(d.w); s[7] -= bf_hi(d.w); }
}
__device__ __forceinline__ void pool_filter(int wave, int prank, int pn) {
    const Ids I = make_ids(wave); const bf16* VB = (const bf16*)(kws() + WS_V); bf16* MIXED = (bf16*)(kws() + WS_MIXED);
    for (int task = prank * NWAVES + I.wave; task < 4 * (M / 64); task += pn * NWAVES) { const int g = task & 3, run4 = task >> 2;
        if (g == 0) pool_task<2>(VB, MIXED, 0, run4, I.lane); else if (g == 1) pool_task<4>(VB, MIXED, 1, run4, I.lane);
        else if (g == 2) pool_task<8>(VB, MIXED, 2, run4, I.lane); else pool_task<16>(VB, MIXED, 3, run4, I.lane); }
}

__device__ __forceinline__ void scan_unit(int l, int un, LAS unsigned char* lds, int wave) {
    const Ids I = make_ids(wave); const int lane = I.lane, h = un >> 2, pm = un & 3, bb = I.wave >> 2, sg = I.wave & 3;
    const float* LT = (const float*)(kws() + WS_LAMT) + (size_t)(l * NH + h) * 128; const float ltr = LT[2 * lane], lti = LT[2 * lane + 1];
    const size_t row0 = (size_t)h * NR + pm * 256 + bb * 128 + sg * 32;
    const float* eb = (const float*)(kws() + WS_E) + row0 * 128; bf16* zb = (bf16*)(kws() + WS_UZ) + row0 * UZK + 256;
    LAS float* xch = (LAS float*)(lds + 32768);
    float zr[32], zi[32], er = 0.f, ei = 0.f;
    {   float a[32], b[32];
#pragma unroll
        for (int i = 0; i < 32; ++i) { a[i] = __builtin_nontemporal_load(eb + (size_t)i * 128 + lane); b[i] = __builtin_nontemporal_load(eb + (size_t)i * 128 + 64 + lane); }
#pragma unroll
        for (int i = 0; i < 32; ++i) { zr[i] = er; zi[i] = ei; const float nr = ltr * er - lti * ei + a[i], ni = ltr * ei + lti * er + b[i]; er = nr; ei = ni; } }
    xch[I.wave * 128 + lane] = er; xch[I.wave * 128 + 64 + lane] = ei;
    float pr = ltr, pi = lti;
#pragma unroll
    for (int q = 0; q < 5; ++q) { const float nr = pr * pr - pi * pi, ni = 2.f * pr * pi; pr = nr; pi = ni; }
    LDS_WAIT(); __syncthreads();
    float cr = 0.f, ci = 0.f;
    for (int s2 = 0; s2 < sg; ++s2) { const float xr = xch[(bb * 4 + s2) * 128 + lane], xi = xch[(bb * 4 + s2) * 128 + 64 + lane]; const float nr = pr * cr - pi * ci + xr, ni = pr * ci + pi * cr + xi; cr = nr; ci = ni; }
    float wr_ = 1.f, wi = 0.f;
#pragma unroll
    for (int i = 0; i < 32; ++i) { const float fr = zr[i] + wr_ * cr - wi * ci, fi = zi[i] + wr_ * ci + wi * cr;
        zb[(size_t)i * UZK + lane] = (bf16)f2bf(fr); zb[(size_t)i * UZK + 64 + lane] = (bf16)f2bf(fi);
        const float nr = wr_ * ltr - wi * lti, ni = wr_ * lti + wi * ltr; wr_ = nr; wi = ni; }
    LDS_WAIT(); __syncthreads();
}
__device__ __forceinline__ void wg_publish_local(bool t0, bool inv) {
    asm volatile("s_waitcnt vmcnt(0)" ::: "memory"); __syncthreads();
    if (inv) { if (t0) { __builtin_amdgcn_fence(__ATOMIC_ACQUIRE, "agent"); asm volatile("s_waitcnt vmcnt(0)" ::: "memory"); }
               __syncthreads(); }
}

constexpr int RT_LD = 2064;
__device__ __forceinline__ void routing_phase(const Ptrs& P, LAS unsigned char* lds, int wave, const int sub0 = -1  , const bool packed = false  ) {
    const Ids I = make_ids(wave); const int lane = I.lane, fr = lane & 15, fq = lane >> 4; unsigned char* ws = kws();
    u32x4* TOK = (u32x4*)(ws + WS_TOK); int* CNT = (int*)(ws + WS_CNT); LAS int* lcnt = (LAS int*)(lds + 16 * RT_LD);
    const bool act = packed || I.wave < 4; const int g0_ = packed ? 2 * I.bx : I.bx;
    for (int grp0 = g0_; grp0 < M / 64; grp0 += packed ? M / 64 : I.G) { const int grp = grp0 + (packed ? (I.wave >> 2) : 0);
        bf16x8 a[32];
        const int m = 64 * grp + 16 * (I.wave & 3) + fr;
        if (act) { const bf16x8* xr = (const bf16x8*)((const bf16*)(ws + WS_XB) + (size_t)m * D + 256 * fq);
#pragma unroll
            for (int s_ = 0; s_ < 32; ++s_) a[s_] = xr[s_]; }
        if (grp0 == g0_) {
            float wv[2][8], gkv[2];
#pragma unroll
            for (int h = 0; h < 2; ++h) { const int k = I.tid + 512 * h; const f32x4 r0 = *(const f32x4*)(kin(20) + (size_t)k * 8), r1 = *(const f32x4*)(kin(20) + (size_t)k * 8 + 4); gkv[h] = kin(16)[D + k];
#pragma unroll
                for (int e = 0; e < 4; ++e) { wv[h][e] = r0[e]; wv[h][4 + e] = r1[e]; } }
#pragma unroll
            for (int h = 0; h < 2; ++h) { const int k = I.tid + 512 * h;
#pragma unroll
                for (int e = 0; e < 8; ++e) { const float w = gkv[h] * wv[h][e]; const unsigned hi = f2bf(w); const float rest = w - u2f(hi << 16);
                    *(LAS unsigned short*)(lds + e * RT_LD + 2 * k) = (unsigned short)hi; *(LAS unsigned short*)(lds + (8 + e) * RT_LD + 2 * k) = (unsigned short)f2bf(rest); } }
        }
        LDS_WAIT(); __syncthreads();
        if (!act && sub0 >= 0) { const int si = I.bx * 4 + (I.wave - 4); moe_subitem_wave(sub0 + (si >> 3), si & 7, ws, (LAS float*)(lds + 65536 + (I.wave - 4) * 16384), lane); }
        if (act) {
            f32x4 acc = (f32x4){0.f, 0.f, 0.f, 0.f}, sq = (f32x4){0.f, 0.f, 0.f, 0.f};
            const LAS unsigned char* bp = lds + fr * RT_LD + 512 * fq;
#pragma unroll
            for (int s_ = 0; s_ < 32; ++s_) { const bf16x8 b = *(const LAS bf16x8*)(bp + 16 * s_);
                acc = __builtin_amdgcn_mfma_f32_16x16x32_bf16(b, a[s_], acc, 0, 0, 0); sq = __builtin_amdgcn_mfma_f32_16x16x32_bf16(a[s_], a[s_], sq, 0, 0, 0); }
            float ssd = (fr & 3) == 0 ? sq[0] : (fr & 3) == 1 ? sq[1] : (fr & 3) == 2 ? sq[2] : sq[3];
            const float ss = __builtin_bit_cast(float, __builtin_amdgcn_ds_bpermute((fr + 16 * (fr >> 2)) << 2, __builtin_bit_cast(int, ssd)));
            const float inv = 1.0f / sqrtf(ss * (1.0f / D) + RMS_EPS);
            float pl[4];
#pragma unroll
            for (int q = 0; q < 4; ++q) pl[q] = (acc[q] + shx(acc[q], lane, 32)) * inv;
            const int eb = 4 * (fq & 1); float v0 = pl[0], v1 = -3.0e38f; int e0 = eb, e1 = -1;
#pragma unroll
            for (int q = 1; q < 4; ++q) { const float v = pl[q]; const int e = eb + q;
                if (v > v0) { v1 = v0; e1 = e0; v0 = v; e0 = e; } else if (v > v1) { v1 = v; e1 = e; } }
            { const float ov0 = shx(v0, lane, 16), ov1 = shx(v1, lane, 16); const int oe0 = __builtin_amdgcn_ds_bpermute((lane ^ 16) << 2, e0), oe1 = __builtin_amdgcn_ds_bpermute((lane ^ 16) << 2, e1);
              const bool ofirst = ov0 > v0 || (ov0 == v0 && oe0 < e0);
              const float w0 = ofirst ? ov0 : v0; const int f0 = ofirst ? oe0 : e0;
              const float c1 = ofirst ? v0 : ov0; const int d1 = ofirst ? e0 : oe0;
              const float c2 = ofirst ? ov1 : v1; const int d2 = ofirst ? oe1 : e1;
              const bool s2 = c2 > c1 || (c2 == c1 && d2 < d1);
              v0 = w0; e0 = f0; v1 = s2 ? c2 : c1; e1 = s2 ? d2 : d1; }
            { unsigned char* x8 = ws + WS_XB8 + (size_t)m * D + 256 * fq; const float sc8 = 8.0f * inv;
#pragma unroll
              for (int s_ = 0; s_ < 32; s_ += 2) { const u32x4 w0 = __builtin_bit_cast(u32x4, a[s_]), w1 = __builtin_bit_cast(u32x4, a[s_ + 1]); u32x4 o8;
                  o8.x = pk4_fp8(sc8 * bf_lo(w0.x), sc8 * bf_hi(w0.x), sc8 * bf_lo(w0.y), sc8 * bf_hi(w0.y)); o8.y = pk4_fp8(sc8 * bf_lo(w0.z), sc8 * bf_hi(w0.z), sc8 * bf_lo(w0.w), sc8 * bf_hi(w0.w));
                  o8.z = pk4_fp8(sc8 * bf_lo(w1.x), sc8 * bf_hi(w1.x), sc8 * bf_lo(w1.y), sc8 * bf_hi(w1.y)); o8.w = pk4_fp8(sc8 * bf_lo(w1.z), sc8 * bf_hi(w1.z), sc8 * bf_lo(w1.w), sc8 * bf_hi(w1.w));
                  *(u32x4*)(x8 + 8 * s_) = o8; } }
            const float x1 = expf(v1 - v0), g0 = 1.0f / (1.0f + x1), g1 = x1 * g0;
            if (fq == 0) { u32x4 t; t.x = (unsigned)e0 | ((unsigned)e1 << 8); t.y = f2u(g0); t.z = f2u(g1); t.w = f2u(inv); TOK[m] = t; }
            int mine = 0;
#pragma unroll
            for (int e = 0; e < 8; ++e) { const int c = __popcll(__ballot(fq == 0 && e0 == e)) + __popcll(__ballot(fq == 0 && e1 == e)); mine = lane == e ? c : mine; }
            if (lane < 8) lcnt[I.wave * 8 + lane] = mine;
        }
        LDS_WAIT(); __syncthreads();
        if (I.tid < (packed ? 16 : 8)) { const int h_ = I.tid >> 3, e_ = I.tid & 7; LAS const int* lc = lcnt + h_ * 32 + e_; CNT[(grp0 + h_) * 8 + e_] = (lc[0] + lc[8]) + (lc[16] + lc[24]); }
        __syncthreads();
    }
}

__device__ __forceinline__ int isum(int v, int lane) {
#pragma unroll
    for (int o = 1; o < 64; o <<= 1) v += __builtin_amdgcn_ds_bpermute((lane ^ o) << 2, v);
    return v;
}
__device__ __forceinline__ void pos_phase(const Ptrs& P, int wave, const bool packed = false  ) {
    const Ids I = make_ids(wave); if (!packed && I.wave != 0) return;
    const int lane = I.lane; unsigned char* ws = kws();
    const u32x4* TOK = (const u32x4*)(ws + WS_TOK); const int* CNT = (const int*)(ws + WS_CNT); int* POS = (int*)(ws + WS_POS); int* ROWTOK = (int*)(ws + WS_ROWTOK); float* ROWINV = (float*)(ws + WS_ROWINV); int* TILES = (int*)(ws + WS_TILES);
    const int vcu = packed ? I.bx * NWAVES + I.wave : I.gw >> 3, vstep = packed ? M / 64 : I.G;
    for (int grp = vcu; grp < M / 64; grp += vstep) {
        int tot[8], pre[8];
#pragma unroll
        for (int e = 0; e < 8; ++e) { tot[e] = 0; pre[e] = 0; }
#pragma unroll
        for (int q = 0; q < 4; ++q) { const int r = lane + 64 * q; const int4 c0 = *(const int4*)(CNT + r * 8), c1 = *(const int4*)(CNT + r * 8 + 4); const int cc[8] = {c0.x, c0.y, c0.z, c0.w, c1.x, c1.y, c1.z, c1.w};
#pragma unroll
            for (int e = 0; e < 8; ++e) { tot[e] += cc[e]; pre[e] += r < grp ? cc[e] : 0; } }
        int off[8], run = 0;
#pragma unroll
        for (int e = 0; e < 8; ++e) { tot[e] = isum(tot[e], lane); pre[e] = isum(pre[e], lane); off[e] = run; run += tot[e]; }
        const int m = 64 * grp + lane; const u32x4 t = TOK[m]; const int e0 = t.x & 0xff, e1 = (t.x >> 8) & 0xff;
        const unsigned long long lt = (1ull << lane) - 1ull; int p0 = 0, p1 = 0; unsigned f0 = 0u, f1 = 0u;
        int pidx = 0;
#pragma unroll
        for (int e = 0; e < 8; ++e) pidx += tot[e] >> 8;
#pragma unroll
        for (int e = 0; e < 8; ++e) { const unsigned long long mk = __ballot(e0 == e || e1 == e); const int k = pre[e] + __popcll(mk & lt), r = off[e] + k;
            const int fullr = tot[e] & ~255; const bool hasp = (tot[e] & 255) != 0;
            const unsigned fl = (hasp && pidx >= 128 && k >= fullr) ? (0x80000000u | ((unsigned)((pidx - 128) * 256 + (k & 255)) << 16)) : 0u;
            p0 = e0 == e ? r : p0; p1 = e1 == e ? r : p1; f0 = e0 == e ? fl : f0; f1 = e1 == e ? fl : f1; pidx += hasp ? 1 : 0; }
        POS[2 * m] = (int)((unsigned)p0 | f0); POS[2 * m + 1] = (int)((unsigned)p1 | f1); ROWTOK[p0] = m; ROWTOK[p1] = m; const unsigned tw = t.w; ROWINV[p0] = u2f(tw); ROWINV[p1] = u2f(tw);
        if (grp == 0) {
#pragma unroll
            for (int q = 0; q < 4; ++q) ROWTOK[NASG + lane + 64 * q] = 0;
            if (lane == 0) { int nt = 0;
                for (int e = 0; e < 8; ++e) for (int k = 0; 256 * (k + 1) <= tot[e]; ++k) { *(int4*)(TILES + 4 * nt) = make_int4(e, off[e] + 256 * k, 256, 0); ++nt; }
                for (int e = 0; e < 8; ++e) if (tot[e] & 255) { *(int4*)(TILES + 4 * nt) = make_int4(e, off[e] + (tot[e] & ~255), tot[e] & 255, 0); ++nt; }
                TILES[255 * 4] = nt; }
        }
    }
}

__device__ __forceinline__ void final_phase(const Ptrs& P, int wave) {
    const Ids I = make_ids(wave); const int lane = I.lane; unsigned char* ws = kws();
    const u32x4* TOK = (const u32x4*)(ws + WS_TOK); const int* POS = (const int*)(ws + WS_POS); const bf16* Y = (const bf16*)(ws + WS_Y);
    const f32x4* gf = (const f32x4*)kin(24) + lane; f32x4 gv[4];
#pragma unroll
    for (int j = 0; j < 4; ++j) gv[j] = gf[64 * j];
    const bool poison = xb_ld((unsigned*)(ws + WS_CTL) + CW_BAR + XB_TMO) != 0u;
#define FIN_REC(tt, qa, qb, mm) do { tt = TOK[mm]; qa = POS[2 * (mm)]; qb = POS[2 * (mm) + 1]; } while (0)
#define FIN_ROWS(hw, ya_, yb_, mm, qa, qb) do { const unsigned q0_ = (unsigned)__builtin_amdgcn_readfirstlane(qa), q1_ = (unsigned)__builtin_amdgcn_readfirstlane(qb); \
        const int p0_ = (q0_ >> 31) ? NASG + (int)((q0_ >> 16) & 0x7fffu) : (int)(q0_ & 0xffffu), p1_ = (q1_ >> 31) ? NASG + (int)((q1_ >> 16) & 0x7fffu) : (int)(q1_ & 0xffffu); \
        const u32x2* hr_ = (const u32x2*)((const bf16*)(ws + WS_XB) + (size_t)(mm) * D) + lane; const u32x2* y0_ = (const u32x2*)(Y + (size_t)p0_ * D) + lane; const u32x2* y1_ = (const u32x2*)(Y + (size_t)p1_ * D) + lane; \
        _Pragma("unroll") for (int j = 0; j < 4; ++j) { hw[j] = hr_[64 * j]; ya_[j] = y0_[64 * j]; yb_[j] = y1_[64 * j]; } } while (0)
    u32x4 tc = (u32x4){0u, 0u, 0u, 0u}, tn = tc; int qc0 = 0, qc1 = 0, qn0 = 0, qn1 = 0;
    u32x2 hwc[4], yac[4], ybc[4];
    if (I.gw < M) { FIN_REC(tc, qc0, qc1, I.gw); if (I.gw + I.NGW < M) FIN_REC(tn, qn0, qn1, I.gw + I.NGW); FIN_ROWS(hwc, yac, ybc, I.gw, qc0, qc1); }
    for (int m = I.gw; m < M; m += I.NGW) { f32x4* xr = (f32x4*)(kout() + (size_t)m * D) + lane; f32x4 v[4]; float ss = 0.f;
        const u32x4 t = tc; const unsigned ty = t.y, tz = t.z; const float g0 = u2f(ty), g1 = u2f(tz); const unsigned q0 = (unsigned)__builtin_amdgcn_readfirstlane(qc0), q1 = (unsigned)__builtin_amdgcn_readfirstlane(qc1);
        const int m1 = m + I.NGW, m2 = m + 2 * I.NGW; u32x4 t2 = tn; int r20 = qn0, r21 = qn1; u32x2 hwn[4], yan[4], ybn[4];
        if (m2 < M) FIN_REC(t2, r20, r21, m2);
        if (m1 < M) FIN_ROWS(hwn, yan, ybn, m1, qn0, qn1);
        const bool s0 = (q0 >> 31) != 0u, s1 = (q1 >> 31) != 0u; const int p0 = s0 ? NASG + (int)((q0 >> 16) & 0x7fffu) : (int)(q0 & 0xffffu), p1 = s1 ? NASG + (int)((q1 >> 16) & 0x7fffu) : (int)(q1 & 0xffffu);
        const u32x2* y0 = (const u32x2*)(Y + (size_t)p0 * D) + lane; const u32x2* y1 = (const u32x2*)(Y + (size_t)p1 * D) + lane;
        f32x4 ya[4], yb[4];
#pragma unroll
        for (int j = 0; j < 4; ++j) { ya[j] = (f32x4){bf_lo(yac[j].x), bf_hi(yac[j].x), bf_lo(yac[j].y), bf_hi(yac[j].y)}; yb[j] = (f32x4){bf_lo(ybc[j].x), bf_hi(ybc[j].x), bf_lo(ybc[j].y), bf_hi(ybc[j].y)}; }
        if (s0 || s1) {
#pragma unroll
            for (int sl = 1; sl < 4; ++sl)
#pragma unroll
                for (int j = 0; j < 4; ++j) {
                    if (s0) { const u32x2 c = y0[64 * j + sl * (2048 * D / 4)]; ya[j] += (f32x4){bf_lo(c.x), bf_hi(c.x), bf_lo(c.y), bf_hi(c.y)}; }
                    if (s1) { const u32x2 c = y1[64 * j + sl * (2048 * D / 4)]; yb[j] += (f32x4){bf_lo(c.x), bf_hi(c.x), bf_lo(c.y), bf_hi(c.y)}; } } }
#pragma unroll
        for (int j = 0; j < 4; ++j) { v[j] = (f32x4){bf_lo(hwc[j].x), bf_hi(hwc[j].x), bf_lo(hwc[j].y), bf_hi(hwc[j].y)};
            v[j][0] += g0 * ya[j][0] + g1 * yb[j][0]; v[j][1] += g0 * ya[j][1] + g1 * yb[j][1]; v[j][2] += g0 * ya[j][2] + g1 * yb[j][2]; v[j][3] += g0 * ya[j][3] + g1 * yb[j][3];
            ss += (v[j][0] * v[j][0] + v[j][1] * v[j][1]) + (v[j][2] * v[j][2] + v[j][3] * v[j][3]); }
        ss = wave_sum(ss, lane); float inv = 1.0f / sqrtf(ss * (1.0f / D) + RMS_EPS); if (poison) inv = __builtin_nanf("");
#pragma unroll
        for (int j = 0; j < 4; ++j) xr[64 * j] = v[j] * inv * gv[j];
        tc = tn; qc0 = qn0; qc1 = qn1; tn = t2; qn0 = r20; qn1 = r21;
#pragma unroll
        for (int j = 0; j < 4; ++j) { hwc[j] = hwn[j]; yac[j] = yan[j]; ybc[j] = ybn[j]; } }
#undef FIN_REC
#undef FIN_ROWS
}

__global__ void __launch_bounds__(NWAVES * 64, 2) trunk_fwd(Ptrs P) {
    extern __shared__ __attribute__((aligned(16))) unsigned char lds_raw[];
    LAS unsigned char* lds = (LAS unsigned char*)lds_raw;
    volatile LAS unsigned* MISC = (volatile LAS unsigned*)(lds + MISC_OFF);
#define OPQ_GB int G = gridDim.x, bx = blockIdx.x; asm volatile("" : "+s"(G), "+s"(bx))
    const int wave0 = __builtin_amdgcn_readfirstlane((int)threadIdx.x >> 6);
    for (int u = threadIdx.x; u < (LDS_BYTES - LDSCTL_OFF) / 4; u += NWAVES * 64) ((LAS unsigned*)(lds + LDSCTL_OFF))[u] = 0u;
    __syncthreads();
    XcdBarrier bar = xcd_barrier_post((unsigned*)(kws() + WS_CTL) + CW_BAR, MISC + 8);
#define GRID_BAR() do { XcdBarrier b_ = bar; asm volatile("" : "+s"(b_.x)); xcd_barrier(b_, wave0 == 0 && hw_lane() == 0); } while (0)

    p0_prologue(P, lds, wave0);
    GRID_BAR();

    for (int l = 0; l < 2; ++l) {
        { unsigned char* ws = kws(); OPQ_GB; pg8::Sched2D S; S.init(ws + WS_XB, (bf16*)(ws + WS_WIN) + (size_t)l * D * D, D * 2, D * 2, M, D, G, bx);
          EpiInProj E{(const float*)(ws + WS_STATS), (bf16*)(ws + WS_UZ), (bf16*)(ws + WS_V)}; pg8::gemm_phase(lds, pg8::GemmP{D * 2, D * 2, D / 64}, S, E, wave0); }
        GRID_BAR();
        { unsigned char* ws = kws(); OPQ_GB;
          if (G == 256 && (bx >> 3) >= 16) {
              const int fr = (bx & 7) * 16 + ((bx >> 3) - 16); pool_filter(wave0, fr, 128);
              if (l == 0) { pro_convert(lds, wave0, fr, 128, 128, PRO_SPLIT); moe_convert_wg(lds, wave0, fr, 128, MOE_TILES, MOE_TILES + 88); }
              moe_convert_wg(lds, wave0, fr, 128, l == 0 ? 0 : MF_C, l == 0 ? MF_A : MF_D);
          } else {
              for (int i = 0;; ++i) { const int un = pg8::head_unit_of(i, G, bx); if (un < 0) break;
                  { pg8::SchedHead S{(const char*)(ws + WS_UZ), (const char*)((bf16*)(ws + WS_WE) + (size_t)l * NH * 256 * 256), (size_t)NR * UZK * 2, (size_t)256 * 256 * 2, UZK * 2, un};
                    EpiE E{(float*)(ws + WS_E)}; pg8::gemm_phase(lds, pg8::GemmP{UZK * 2, 256 * 2, 4}, S, E, wave0); }
                  wg_publish_local(wave0 == 0 && hw_lane() == 0, false);
                  { pg8::SchedHead S{(const char*)(ws + WS_UZ), (const char*)((bf16*)(ws + WS_TW) + (size_t)l * NH * 256 * UZK), (size_t)NR * UZK * 2, (size_t)256 * UZK * 2, UZK * 2, un};
                    EpiY E{(bf16*)(ws + WS_H)}; pg8::gemm_phase<EpiY, pg8::SchedHead, false, 1>(lds, pg8::GemmP{UZK * 2, UZK * 2, UZK / 64}, S, E, wave0); }
                  scan_unit(l, un, lds, wave0);
                  wg_publish_local(wave0 == 0 && hw_lane() == 0, true);
                  { pg8::SchedHead S{(const char*)(ws + WS_UZ), (const char*)((bf16*)(ws + WS_TW) + (size_t)l * NH * 256 * UZK), (size_t)NR * UZK * 2, (size_t)256 * UZK * 2, UZK * 2, un};
                    EpiY E{(bf16*)(ws + WS_H)}; pg8::gemm_phase<EpiY, pg8::SchedHead, false, 2>(lds, pg8::GemmP{UZK * 2, UZK * 2, UZK / 64}, S, E, wave0); } }
              if (G == 256 && l == 0) pro_convert(lds, wave0, (bx & 7) * 16 + (bx >> 3), 128, PRO_SPLIT, 896 + 2 * 704);
              if (G != 256) { pool_filter(wave0, bx, G); if (l == 0) { pro_convert(lds, wave0, bx, G); moe_convert_wg(lds, wave0, bx, G, MOE_TILES, MOE_TILES + 88); } moe_convert_wg(lds, wave0, bx, G, l == 0 ? 0 : MF_C, l == 0 ? MF_A : MF_D); } } }
        GRID_BAR();
        { unsigned char* ws = kws(); OPQ_GB; pg8::Sched2D S; S.init(ws + WS_H, (bf16*)(ws + WS_WGLU) + (size_t)l * 512 * 512, DSSM * 2, DSSM * 2, M, DSSM, G, bx);
          EpiGlu E{(const bf16*)(ws + WS_H), kin(12) + l * DSSM, (bf16*)(ws + WS_MIXED)}; pg8::gemm_phase(lds, pg8::GemmP{DSSM * 2, DSSM * 2, DSSM / 64}, S, E, wave0);
          { const bool part = G > 128; if (!part || bx >= 128) { const int fr = part ? bx - 128 : bx, nf = part ? G - 128 : G;
              if (l == 0) misc_fill(P, lds, wave0, fr, nf);
              moe_convert_wg(lds, wave0, fr, nf, l == 0 ? MF_A : MF_D, l == 0 ? MF_B : (G == 256 ? MT_END - MT_POS - MT_RT : MT_END)); }
            } }
        GRID_BAR();
        { unsigned char* ws = kws(); OPQ_GB; pg8::Sched2D S; S.init(ws + WS_MIXED, (bf16*)(ws + WS_WOUT) + (size_t)l * D * D, D * 2, D * 2, M, D, G, bx);
          EpiRes E{nullptr, (bf16*)(ws + WS_XB), (float*)(ws + WS_STATS), nullptr};     pg8::gemm_phase(lds, pg8::GemmP{D * 2, D * 2, D / 64}, S, E, wave0); }
        GRID_BAR();
        if (l == 0) {
            { unsigned char* ws = kws(); OPQ_GB; pg8::Sched2D S; S.init(ws + WS_XB, ws + WS_WGU, D * 2, D * 2, M, 2 * DFF, G, bx);
              EpiUp E{(const float*)(ws + WS_STATS), ws + WS_HID}; pg8::gemm_phase(lds, pg8::GemmP{D * 2, D * 2, D / 64}, S, E, wave0);
              { constexpr int NU = (M / 256) * (2 * DFF / 256); const int rem = NU % G;
                if (rem != 0) { if (bx >= rem) moe_convert_wg(lds, wave0, bx - rem, G - rem, MF_B, MF_C); } else moe_convert_wg(lds, wave0, bx, G, MF_B, MF_C); } }
            GRID_BAR();
            { unsigned char* ws = kws(); OPQ_GB; pg8::Sched2D S; S.init(ws + WS_HID, ws + WS_WD, DFF, DFF, M, D, G, bx);
              EpiRes E{nullptr, (bf16*)(ws + WS_XB), (float*)(ws + WS_STATS), nullptr}; pg8::gemm_phase<EpiRes, pg8::Sched2D, true>(lds, pg8::GemmP{DFF, DFF, DFF / 128}, S, E, wave0); }
            GRID_BAR();
        }
    }
    { OPQ_GB; if (G == 256) routing_phase(P, lds, wave0, MT_END - MT_POS - MT_RT); else routing_phase(P, lds, wave0); }
    GRID_BAR();
    { OPQ_GB; if (G == 256) { if (bx < 32) pos_phase(P, wave0, true); else moe_convert_wg(lds, wave0, bx - 32, 224, MT_END - MT_POS, MT_END); } else pos_phase(P, wave0); }
    GRID_BAR();
    { unsigned char* ws = kws(); OPQ_GB; pg8::SchedMoe<true> S; S.init(lds, wave0 * 64 + hw_lane(), ws + WS_XB8, ws + WS_MWGU, (size_t)2 * DFF * D, D, D, 2 * DFF, G, bx);
      EpiUpMoe E{ws + WS_HIDM}; pg8::gemm_phase<EpiUpMoe, pg8::SchedMoe<true>, true>(lds, pg8::GemmP{D, D, D / 128}, S, E, wave0);
      { const int rem = S.nwg % G, nidle = G - rem;
        if (rem != 0 && 2 * nidle >= G) { if (bx >= rem) moe_convert_wg(lds, wave0, bx - rem, nidle, MT_END, MOE_TILES); } else moe_convert_wg(lds, wave0, bx, G, MT_END, MOE_TILES); } }
    GRID_BAR();
    { unsigned char* ws = kws(); OPQ_GB; pg8::SchedMoe<false> S; S.init(lds, wave0 * 64 + hw_lane(), ws + WS_HIDM, ws + WS_MWD, (size_t)D * DFF, DFF, DFF, D, G, bx);
      EpiDownMoe E{(bf16*)(ws + WS_Y)}; pg8::gemm_phase<EpiDownMoe, pg8::SchedMoe<false>, true>(lds, pg8::GemmP{DFF, DFF, DFF / 128}, S, E, wave0); }
    GRID_BAR();
    final_phase(P, wave0);
}

extern "C" void kernel_launch(void* const* d_in, const int* in_sizes, int n_in, void* d_out, int out_size, void* d_ws, size_t ws_size, hipStream_t stream) {
    static int grid = 0;
    if (grid == 0) {
        if (n_in != 25 || in_sizes[0] != M * D || out_size != M * D || ws_size < WS_END) { fprintf(stderr, "kernel_launch: unexpected shapes / workspace (n_in %d, ws %zu)\n", n_in, ws_size); grid = -1; return; }
        int dev = 0, cus = 0, per_cu = 0;
        if (hipGetDevice(&dev) != hipSuccess || hipDeviceGetAttribute(&cus, hipDeviceAttributeMultiprocessorCount, dev) != hipSuccess) { grid = -1; return; }
        if (hipFuncSetAttribute((const void*)trunk_fwd, hipFuncAttributeMaxDynamicSharedMemorySize, LDS_BYTES) != hipSuccess) { grid = -1; return; }
        if (hipOccupancyMaxActiveBlocksPerMultiprocessor(&per_cu, (const void*)trunk_fwd, NWAVES * 64, LDS_BYTES) != hipSuccess || per_cu < 1) { fprintf(stderr, "kernel_launch: occupancy query says %d\n", per_cu); }
        (void)hipGetLastError();
        grid = cus;
    }
    if (grid < 0) return;
    (void)hipMemsetAsync((char*)d_ws + WS_CTL, 0, CTL_ZERO_BYTES, stream);
    Ptrs p{};
    for (int i = 0; i < 25; ++i) p.in[i] = (const float*)d_in[i];
    p.out = (float*)d_out; p.ws = (unsigned char*)d_ws;
    hipLaunchKernelGGL(trunk_fwd, dim3(grid), dim3(NWAVES * 64), LDS_BYTES, stream, p);
}
```
